# Optimizing an MI355X kernel written in HIP

```python
import math
import jax, jax.numpy as jnp
from jax import lax
import numpy as np

D_MODEL = 2048
BATCH = 8
SEQ = 4096
DEPTH = 4

GRID_W = 64
CTX_LEN = 256
N_MIXERS = 3
N_LAYERS_GLA = (DEPTH + 2) // 3
N_LAYERS_MLA = (DEPTH + 1) // 3
N_LAYERS_SWA = DEPTH // 3
EPS = 1e-6
ROPE_THETA = 10000.0
ROPE_DIM = 64
BLOCK = 128
D_FF = -(-8 * D_MODEL // (3 * 256)) * 256
GLA_HEADS = 4
GLA_DK = D_MODEL // 2 // GLA_HEADS
GLA_DV = D_MODEL // GLA_HEADS
GLA_QK = GLA_HEADS * GLA_DK
GLA_VD = GLA_HEADS * GLA_DV
GLA_GATE_RANK = 16
GLA_TAU = 16.0
GLA_CHUNK = 64
MLA_HEADS = D_MODEL // 128
MLA_Q_RANK = 512
MLA_KV_RANK = 512
MLA_NOPE = 128
MLA_ROPE = ROPE_DIM
MLA_V = 128
MLA_SCALE = (MLA_NOPE + MLA_ROPE) ** -0.5
SWA_HEADS = D_MODEL // 64
SWA_KV_HEADS = SWA_HEADS // 8
SWA_GROUP = SWA_HEADS // SWA_KV_HEADS
SWA_HEAD_DIM = 64
SWA_SCALE = SWA_HEAD_DIM ** -0.5
WINDOW = 128

kernel_name = "hybrid_gla_mla_swa_dit_trunk"


def rmsnorm(x, g):
    xf = x.astype(jnp.float32)
    y = xf * lax.rsqrt(jnp.mean(xf * xf, axis=-1, keepdims=True) + EPS)
    return (y * g.astype(jnp.float32)).astype(x.dtype)


def modulation(cond, w_ada, b_ada):
    m = jax.nn.silu(cond) @ w_ada + b_ada
    return jnp.split(m, 6, axis=-1)


def adaln_in(h, g, shift, scale):
    return rmsnorm(h, g) * (1 + scale) + shift


def axial_rope_tables(n_rows):
    row = jnp.repeat(jnp.arange(n_rows), GRID_W).astype(jnp.float32)
    col = jnp.tile(jnp.arange(GRID_W), n_rows).astype(jnp.float32)
    n_freq = ROPE_DIM // 4
    inv_freq = ROPE_THETA ** (-jnp.arange(n_freq, dtype=jnp.float32) / n_freq)
    ang = jnp.concatenate([row[:, None] * inv_freq, col[:, None] * inv_freq], axis=-1)
    return jnp.cos(ang), jnp.sin(ang)


def apply_rope(x, cos, sin):
    x1, x2 = jnp.split(x, 2, axis=-1)
    cos = cos.astype(x.dtype)
    sin = sin.astype(x.dtype)
    return jnp.concatenate([x1 * cos - x2 * sin, x2 * cos + x1 * sin], axis=-1)


def _split_heads(a, n):
    return a.reshape(a.shape[:-1] + (n, a.shape[-1] // n))


def _to_blocks(a):
    return jnp.moveaxis(a.reshape((a.shape[0], a.shape[1] // BLOCK, BLOCK) + a.shape[2:]), 1, 0)


def _from_blocks(o):
    o = jnp.moveaxis(o, 0, 1)
    return o.reshape(o.shape[0], o.shape[1] * o.shape[2], -1)


def swiglu(h, w_in, w_out):
    g, u = jnp.split(h @ w_in, 2, axis=-1)
    return (jax.nn.silu(g) * u) @ w_out


def gla_chunked(q, k, v, lg, s0):
    out_dtype = v.dtype
    causal = jnp.tril(jnp.ones((GLA_CHUNK, GLA_CHUNK), bool))

    def to_chunks(a):
        b_, h_, t_, d_ = a.shape
        return jnp.moveaxis(a.reshape(b_, h_, t_ // GLA_CHUNK, GLA_CHUNK, d_), 2, 0)

    def step(s, inp):
        qc, kc, vc, gc = [t.astype(jnp.float32) for t in inp]
        b = jnp.cumsum(gc, axis=2)
        o_inter = jnp.einsum('bhcd,bhde->bhce', qc * jnp.exp(b), s)
        diff = jnp.where(causal[:, :, None], b[:, :, :, None, :] - b[:, :, None, :, :], -jnp.inf)
        decay = jnp.exp(diff)
        attn = jnp.einsum('bhijd,bhjd->bhij', qc[:, :, :, None, :] * decay, kc)
        o_intra = jnp.einsum('bhij,bhje->bhie', attn, vc)
        b_last = b[:, :, -1:, :]
        k_dec = kc * jnp.exp(b_last - b)
        s_new = jnp.exp(b_last[:, :, 0, :])[..., None] * s + jnp.einsum('bhcd,bhce->bhde', k_dec, vc)
        return s_new, o_inter + o_intra

    s_fin, o = lax.scan(step, s0, (to_chunks(q), to_chunks(k), to_chunks(v), to_chunks(lg)))
    o = jnp.moveaxis(o, 0, 2)
    o = o.reshape(o.shape[0], o.shape[1], -1, o.shape[-1]).astype(out_dtype)
    return o, s_fin


def gla_mixer(h_ctx, h_lat, w_in, w_gate_down, w_gate_up, b_gate, g_head, w_out, with_ctx_out):
    def heads(a):
        return jnp.swapaxes(_split_heads(a, GLA_HEADS), 1, 2)

    def project(h):
        q, k, v, r = jnp.split(h @ w_in, [GLA_QK, 2 * GLA_QK, 2 * GLA_QK + GLA_VD], axis=-1)
        lg = [heads(jax.nn.log_sigmoid(((h @ w_gate_down[d]) @ w_gate_up[d] + b_gate[d]).astype(jnp.float32)) / GLA_TAU)
              for d in range(2)]
        return heads(q) * (GLA_DK ** -0.5), heads(k), heads(v), r, lg

    qc, kc, vc, rc, lgc = project(h_ctx)
    ql, kl, vl, rl, lgl = project(h_lat)
    s0 = jnp.zeros(qc.shape[:2] + (GLA_DK, GLA_DV), jnp.float32)
    flip = lambda a: jnp.flip(a, axis=2)
    oc_f, sc_f = gla_chunked(qc, kc, vc, lgc[0], s0)
    ol_f, _ = gla_chunked(ql, kl, vl, lgl[0], sc_f)
    oc_b, sc_b = gla_chunked(flip(qc), flip(kc), flip(vc), flip(lgc[1]), s0)
    ol_b, _ = gla_chunked(flip(ql), flip(kl), flip(vl), flip(lgl[1]), sc_b)

    def out(o_f, o_b, r):
        o = rmsnorm(o_f + flip(o_b), g_head)
        o = jnp.swapaxes(o, 1, 2).reshape(r.shape[:-1] + (GLA_VD,))
        return (o * jax.nn.silu(r)) @ w_out

    y_lat = out(ol_f, ol_b, rl)
    y_ctx = out(oc_f, oc_b, rc) if with_ctx_out else None
    return y_ctx, y_lat


def mla_mixer(h_ctx, h_lat, cos, sin, w_in, g_q, w_uq, g_kv, w_ukv, w_out, with_ctx_out):
    def project(h, rotate):
        cq, ckv, k_rope = jnp.split(h @ w_in, [MLA_Q_RANK, MLA_Q_RANK + MLA_KV_RANK], axis=-1)
        q = _split_heads(rmsnorm(cq, g_q) @ w_uq, MLA_HEADS)
        kv = _split_heads(rmsnorm(ckv, g_kv) @ w_ukv, MLA_HEADS)
        q_nope, q_rope = jnp.split(q, [MLA_NOPE], axis=-1)
        k_nope, v = jnp.split(kv, [MLA_NOPE], axis=-1)
        if rotate:
            q_rope = apply_rope(q_rope, cos[:, None, :], sin[:, None, :])
            k_rope = apply_rope(k_rope, cos, sin)
        return q_nope, q_rope, k_nope, k_rope, v

    def attend(qn, qr, kn, kr, v):
        s = jnp.einsum('bqhd,bkhd->bhqk', qn, kn) + jnp.einsum('bqhr,bkr->bhqk', qr, kr)
        p = jax.nn.softmax(s.astype(jnp.float32) * MLA_SCALE, axis=-1).astype(v.dtype)
        return jnp.einsum('bhqk,bkhd->bqhd', p, v)

    qn_c, qr_c, kn_c, kr_c, v_c = project(h_ctx, False)
    qn_l, qr_l, kn_l, kr_l, v_l = project(h_lat, True)
    kn_all = jnp.concatenate([kn_c, kn_l], axis=1)
    kr_all = jnp.concatenate([kr_c, kr_l], axis=1)
    v_all = jnp.concatenate([v_c, v_l], axis=1)
    o = lax.map(lambda qb: attend(qb[0], qb[1], kn_all, kr_all, v_all), (_to_blocks(qn_l), _to_blocks(qr_l)))
    y_lat = _from_blocks(o) @ w_out
    if with_ctx_out:
        o_c = attend(qn_c, qr_c, kn_c, kr_c, v_c)
        y_ctx = o_c.reshape(o_c.shape[0], o_c.shape[1], -1) @ w_out
    else:
        y_ctx = None
    return y_ctx, y_lat


def swa_mixer(h_ctx, h_lat, cos, sin, w_in, sinks, w_out, with_ctx_out):
    def project(h, rotate):
        q, k, v = jnp.split(h @ w_in, [SWA_HEADS * SWA_HEAD_DIM, (SWA_HEADS + SWA_KV_HEADS) * SWA_HEAD_DIM], axis=-1)
        q = q.reshape(q.shape[:-1] + (SWA_KV_HEADS, SWA_GROUP, SWA_HEAD_DIM))
        k = _split_heads(k, SWA_KV_HEADS)
        v = _split_heads(v, SWA_KV_HEADS)
        if rotate:
            q = apply_rope(q, cos[:, None, None, :], sin[:, None, None, :])
            k = apply_rope(k, cos[:, None, :], sin[:, None, :])
        return q, k, v

    sink = sinks.reshape(SWA_KV_HEADS, SWA_GROUP).astype(jnp.float32)

    def attend(q, k, v, mask):
        s = jnp.einsum('bqngd,bknd->bngqk', q, k).astype(jnp.float32) * SWA_SCALE
        if mask is not None:
            s = jnp.where(mask, s, -jnp.inf)
        sink_col = jnp.broadcast_to(sink[None, :, :, None, None], s.shape[:-1] + (1,))
        p = jax.nn.softmax(jnp.concatenate([s, sink_col], axis=-1), axis=-1)[..., :-1].astype(v.dtype)
        return jnp.einsum('bngqk,bknd->bqngd', p, v)

    q_c, k_c, v_c = project(h_ctx, False)
    q_l, k_l, v_l = project(h_lat, True)
    t_lat = h_lat.shape[1]
    pad = ((0, 0), (BLOCK, BLOCK), (0, 0), (0, 0))
    k_pad = jnp.pad(k_l, pad)
    v_pad = jnp.pad(v_l, pad)
    a_idx = jnp.arange(BLOCK)
    b_idx = jnp.arange(3 * BLOCK)
    band = jnp.abs(a_idx[:, None] - b_idx[None, :] + BLOCK) <= WINDOW
    ctx_cols = jnp.ones((BLOCK, k_c.shape[1]), bool)

    def block(args):
        qb, n = args
        kb = lax.dynamic_slice_in_dim(k_pad, n * BLOCK, 3 * BLOCK, axis=1)
        vb = lax.dynamic_slice_in_dim(v_pad, n * BLOCK, 3 * BLOCK, axis=1)
        kpos = (n - 1) * BLOCK + b_idx
        valid = band & ((kpos >= 0) & (kpos < t_lat))[None, :]
        mask = jnp.concatenate([ctx_cols, valid], axis=1)
        return attend(qb, jnp.concatenate([k_c, kb], axis=1), jnp.concatenate([v_c, vb], axis=1), mask)

    o = lax.map(block, (_to_blocks(q_l), jnp.arange(t_lat // BLOCK)))
    y_lat = _from_blocks(o) @ w_out
    if with_ctx_out:
        o_c = attend(q_c, k_c, v_c, None)
        y_ctx = o_c.reshape(o_c.shape[0], o_c.shape[1], -1) @ w_out
    else:
        y_ctx = None
    return y_ctx, y_lat


def setup_inputs(seed: int = 0) -> dict:
    key = jax.random.key(seed)
    ks = iter(jax.random.split(key, 32))
    D = D_MODEL

    def nrm(shape, scale=1.0):
        return jax.random.normal(next(ks), shape, jnp.float32) * scale

    def gain(shape):
        return 1.0 + nrm(shape, 0.02)

    return {
        "x": nrm((BATCH, SEQ, D)),
        "c": nrm((BATCH, D)),
        "ctx": nrm((BATCH, CTX_LEN, D)),
        "c_ctx": nrm((D,)),
        "w_ada": nrm((DEPTH, D, 6 * D), 0.5 * D ** -0.5),
        "b_ada": nrm((DEPTH, 6 * D), 0.01),
        "g_norm": gain((DEPTH, 4, D)),
        "w_ffn_in": nrm((DEPTH, D, 2 * D_FF), D ** -0.5),
        "w_ffn_out": nrm((DEPTH, D_FF, D), D_FF ** -0.5),
        "gla_w_in": nrm((N_LAYERS_GLA, D, 2 * GLA_QK + 2 * GLA_VD), D ** -0.5),
        "gla_w_gate_down": nrm((N_LAYERS_GLA, 2, D, GLA_GATE_RANK), D ** -0.5),
        "gla_w_gate_up": nrm((N_LAYERS_GLA, 2, GLA_GATE_RANK, GLA_QK), GLA_GATE_RANK ** -0.5),
        "gla_b_gate": nrm((N_LAYERS_GLA, 2, GLA_QK), 0.1),
        "gla_g_head": gain((N_LAYERS_GLA, GLA_DV)),
        "gla_w_out": nrm((N_LAYERS_GLA, GLA_VD, D), GLA_VD ** -0.5),
        "mla_w_in": nrm((N_LAYERS_MLA, D, MLA_Q_RANK + MLA_KV_RANK + MLA_ROPE), D ** -0.5),
        "mla_g_q": gain((N_LAYERS_MLA, MLA_Q_RANK)),
        "mla_w_uq": nrm((N_LAYERS_MLA, MLA_Q_RANK, MLA_HEADS * (MLA_NOPE + MLA_ROPE)), MLA_Q_RANK ** -0.5),
        "mla_g_kv": gain((N_LAYERS_MLA, MLA_KV_RANK)),
        "mla_w_ukv": nrm((N_LAYERS_MLA, MLA_KV_RANK, MLA_HEADS * (MLA_NOPE + MLA_V)), MLA_KV_RANK ** -0.5),
        "mla_w_out": nrm((N_LAYERS_MLA, MLA_HEADS * MLA_V, D), (MLA_HEADS * MLA_V) ** -0.5),
        "swa_w_in": nrm((N_LAYERS_SWA, D, (SWA_HEADS + 2 * SWA_KV_HEADS) * SWA_HEAD_DIM), D ** -0.5),
        "swa_sinks": nrm((N_LAYERS_SWA, SWA_HEADS)),
        "swa_w_out": nrm((N_LAYERS_SWA, SWA_HEADS * SWA_HEAD_DIM, D), (SWA_HEADS * SWA_HEAD_DIM) ** -0.5),
    }


def reference(x, c, ctx, c_ctx, w_ada, b_ada, g_norm, w_ffn_in, w_ffn_out,
              gla_w_in, gla_w_gate_down, gla_w_gate_up, gla_b_gate, gla_g_head, gla_w_out,
              mla_w_in, mla_g_q, mla_w_uq, mla_g_kv, mla_w_ukv, mla_w_out,
              swa_w_in, swa_sinks, swa_w_out):
    ROWS = x.shape[1] // GRID_W
    cos, sin = axial_rope_tables(ROWS)
    h_lat, h_ctx = x, ctx
    for i in range(DEPTH):
        kind, j = i % N_MIXERS, i // N_MIXERS
        last = i == DEPTH - 1
        ml = [t[:, None, :] for t in modulation(c, w_ada[i], b_ada[i])]
        mc = modulation(c_ctx, w_ada[i], b_ada[i])
        a_lat = adaln_in(h_lat, g_norm[i, 0], ml[0], ml[1])
        a_ctx = adaln_in(h_ctx, g_norm[i, 0], mc[0], mc[1])
        if kind == 0:
            y_ctx, y_lat = gla_mixer(a_ctx, a_lat, gla_w_in[j], gla_w_gate_down[j], gla_w_gate_up[j],
                                     gla_b_gate[j], gla_g_head[j], gla_w_out[j], not last)
        elif kind == 1:
            y_ctx, y_lat = mla_mixer(a_ctx, a_lat, cos, sin, mla_w_in[j], mla_g_q[j], mla_w_uq[j],
                                     mla_g_kv[j], mla_w_ukv[j], mla_w_out[j], not last)
        else:
            y_ctx, y_lat = swa_mixer(a_ctx, a_lat, cos, sin, swa_w_in[j], swa_sinks[j], swa_w_out[j], not last)
        h_lat = h_lat + ml[2] * rmsnorm(y_lat, g_norm[i, 1])
        f_lat = swiglu(adaln_in(h_lat, g_norm[i, 2], ml[3], ml[4]), w_ffn_in[i], w_ffn_out[i])
        h_lat = h_lat + ml[5] * rmsnorm(f_lat, g_norm[i, 3])
        if not last:
            h_ctx = h_ctx + mc[2] * rmsnorm(y_ctx, g_norm[i, 1])
            f_ctx = swiglu(adaln_in(h_ctx, g_norm[i, 2], mc[3], mc[4]), w_ffn_in[i], w_ffn_out[i])
            h_ctx = h_ctx + mc[5] * rmsnorm(f_ctx, g_norm[i, 3])
    return h_lat
```

```cpp
#include <hip/hip_runtime.h>
#include <cstdio>
#include <cstdint>
#include <type_traits>

#ifndef REP_MASK
#define REP_MASK 0
#endif
#define REPN(bit) ((REP_MASK & (bit)) ? 2 : 1)
#ifndef MK_ONE_LAUNCH
#define MK_ONE_LAUNCH 1
#endif

__device__ __forceinline__ int hw_lane() { int l; asm volatile("v_mbcnt_lo_u32_b32 %0, -1, 0\n\tv_mbcnt_hi_u32_b32 %0, -1, %0" : "=v"(l)); return l; }
__device__ __forceinline__ int hw_tid(int wave) { asm volatile("" : "+s"(wave)); return wave * 64 + hw_lane(); }

namespace pg8 {
#define PG8_LAS __attribute__((address_space(3)))
typedef unsigned short bf16_t;
typedef short bf16x8 __attribute__((ext_vector_type(8)));
typedef float f32x4 __attribute__((ext_vector_type(4)));
typedef unsigned u32x4 __attribute__((ext_vector_type(4)));
constexpr int BM = 256, BK = 64, HALF = 128, HTB = HALF * BK * 2, STAGE_BYTES = 8 * HTB, NXCD = 8, WGM = 8;

__host__ __device__ __forceinline__ int lds_byte(int r, int c) { const int st = (r >> 4) * 2 + (c >> 5), rr = r & 15, cc = c & 31, ob = rr * 64 + cc * 2; return st * 1024 + (ob ^ (((ob >> 9) & 1) << 5)); }
__host__ __device__ __forceinline__ void stage_rc(int b, int& R, int& C) { const int st = b / 1024, sb = b % 1024, swz = sb ^ (((sb >> 9) & 1) << 5); R = (st >> 1) * 16 + swz / 64; C = (st & 1) * 32 + (swz % 64) / 2; }
__host__ __device__ __forceinline__ int perm32(int rho) { const int n = rho >> 4, i = rho & 15; return 8 * (i >> 2) + 4 * n + (i & 3); }

struct Unit { int pm, pn, ko, ks, hm; };
struct Gemm { const bf16_t* A; const bf16_t* Bt; int M, N, K, lda, ldb; };

struct StaticOrder {
    int nM, nN, nwg, G, c;
    __host__ __device__ void init(int M, int N, int G_, int c_) { nM = M / BM; nN = N / BM; nwg = nM * nN; G = G_; c = c_; }
    __host__ __device__ void at(int L, Unit& u) const {
        int wgid = L; { const int q = nwg / NXCD, r = nwg % NXCD, xcd = wgid % NXCD, off = wgid / NXCD; wgid = (xcd < r ? xcd * (q + 1) : r * (q + 1) + (xcd - r) * q) + off; }
        const int nig = WGM * nN, gid = wgid / nig, fm = gid * WGM, gsz = (nM - fm) < WGM ? (nM - fm) : WGM;
        u.pm = fm + ((wgid % nig) % gsz); u.pn = (wgid % nig) / gsz; u.ko = 0; u.ks = -1; u.hm = 0;
    }
    __host__ __device__ bool next(int i, Unit& u) const { const long L = (long)i * G + c; if (L >= nwg) return false; at((int)L, u); return true; }
    __device__ __forceinline__ void a_ready(const Unit&) const {}
    __device__ __forceinline__ void done(const Unit&) const {}
};
struct TailOrder {
    StaticOrder S; int nfull, R;
    __host__ __device__ void init(int M, int N, int G_, int c_) { S.init(M, N, G_, c_); nfull = (S.nwg / G_) * G_; R = S.nwg - nfull; if (2 * R > G_) { nfull = S.nwg; R = 0; } }
    __host__ __device__ bool next(int i, Unit& u) const {
        const long L = (long)i * S.G + S.c;
        if (L < nfull) { S.at((int)L, u); return true; }
        const int r = (int)(L - nfull); if (r >= 2 * R) return false;
        S.at(nfull + (r >= R ? r - R : r), u); u.hm = r >= R ? 2 : 1; return true;
    }
    __device__ __forceinline__ void a_ready(const Unit&) const {}
    __device__ __forceinline__ void done(const Unit&) const {}
};

struct SplitOrder {
    StaticOrder S; int nmain, nsplit, nN, pm0, kq;
    __host__ __device__ void init(int Mmain, int Mextra, int N, int K, int G_, int c_) { S.init(Mmain, N, G_, c_); nmain = S.nwg; nN = N / BM; nsplit = (Mextra / BM) * nN * 4; pm0 = Mmain / BM; kq = K / 4; }
    __host__ __device__ bool next(int i, Unit& u) const {
        const long L = (long)i * S.G + S.c;
        if (L < nmain) return S.next(i, u);
        const int r = (int)(L - nmain); if (r >= nsplit) return false;
        const int per = nsplit >> 2, ks = r / per, rest = r % per, nme = per / nN;
        u.pm = pm0 + rest % nme; u.pn = rest / nme; u.ko = ks * kq; u.ks = ks; u.hm = 0; return true;
    }
    __device__ __forceinline__ void a_ready(const Unit&) const {}
    __device__ __forceinline__ void done(const Unit&) const {}
};

__device__ __forceinline__ unsigned cvt_pk_bf16(float lo, float hi) { unsigned r; asm volatile("v_cvt_pk_bf16_f32 %0, %1, %2" : "=v"(r) : "v"(lo), "v"(hi)); return r; }

__device__ __forceinline__ float logsig16(float z) { return (fminf(z, 0.f) - __logf(1.0f + __expf(-fabsf(z)))) * 0.0625f; }
__device__ __forceinline__ float silu_mul(float g, float u) { return g * __builtin_amdgcn_rcpf(1.0f + __expf(-g)) * u; }
typedef float f32x2 __attribute__((ext_vector_type(2)));
__device__ __forceinline__ f32x2 silu_mul2(f32x2 g, f32x2 u) { const f32x2 t = g * (f32x2){-1.4426950408889634f, -1.4426950408889634f};
    f32x2 e = {__builtin_amdgcn_exp2f(t.x), __builtin_amdgcn_exp2f(t.y)}; e = e + (f32x2){1.0f, 1.0f};
    const f32x2 r = {__builtin_amdgcn_rcpf(e.x), __builtin_amdgcn_rcpf(e.y)}; return (g * u) * r; }

struct EpiPlain {
    static constexpr bool PERM = true, AFTER_DRAIN = false;
    bf16_t* O; int ldc; float* part; int prow0, prows;
    __device__ __forceinline__ void partial(const f32x4 (&acc)[2][2][4][2], const Unit& u, int wr, int wc, int fr, int fq) const {
        const int row0 = u.pm * BM + wr * 64 + fr - prow0, col0 = u.pn * BM + wc * 32 + 8 * fq;
        float* base = part + (size_t)u.ks * prows * ldc;
#pragma unroll
        for (int ai = 0; ai < 2; ++ai)
#pragma unroll
            for (int m = 0; m < 4; ++m) { float* rowp = base + (size_t)(row0 + ai * HALF + m * 16) * ldc + col0;
#pragma unroll
                for (int bj = 0; bj < 2; ++bj) { *(f32x4*)(rowp + bj * HALF) = acc[ai][bj][m][0]; *(f32x4*)(rowp + bj * HALF + 4) = acc[ai][bj][m][1]; } }
    }
    __device__ __forceinline__ void operator()(const f32x4 (&acc)[2][2][4][2], const Unit& u, int wr, int wc, int fr, int fq) const {
        const int row0 = u.pm * BM + wr * 64 + fr, col0 = u.pn * BM + wc * 32 + 8 * fq;
#pragma unroll
        for (int ai = 0; ai < 2; ++ai) { if (u.hm == 2 - ai) continue;
#pragma unroll
            for (int m = 0; m < 4; ++m) { bf16_t* rowp = O + (size_t)(row0 + ai * HALF + m * 16) * ldc + col0;
#pragma unroll
                for (int bj = 0; bj < 2; ++bj) { const f32x4 v0 = acc[ai][bj][m][0], v1 = acc[ai][bj][m][1];
                    u32x4 w; w.x = cvt_pk_bf16(v0[0], v0[1]); w.y = cvt_pk_bf16(v0[2], v0[3]); w.z = cvt_pk_bf16(v1[0], v1[1]); w.w = cvt_pk_bf16(v1[2], v1[3]);
                    *(u32x4*)(rowp + bj * HALF) = w; } } }
    }
};
struct EpiGlaIn {
    static constexpr bool PERM = true, AFTER_DRAIN = false;
    bf16_t* O; int ldc; float* U;
    __device__ __forceinline__ void operator()(const f32x4 (&acc)[2][2][4][2], const Unit& u, int wr, int wc, int fr, int fq) const {
        const int row0 = u.pm * BM + wr * 64 + fr, col0 = u.pn * BM + wc * 32 + 8 * fq;
        if (u.pn == 24) {
            if (wc == 0) {
#pragma unroll
                for (int ai = 0; ai < 2; ++ai) { if (u.hm == 2 - ai) continue;
#pragma unroll
                    for (int m = 0; m < 4; ++m) { float* up = U + (size_t)(row0 + ai * HALF + m * 16) * 32 + 8 * fq; *(f32x4*)up = acc[ai][0][m][0]; *(f32x4*)(up + 4) = acc[ai][0][m][1]; } }
            }
            return;
        }
#pragma unroll
        for (int ai = 0; ai < 2; ++ai) { if (u.hm == 2 - ai) continue;
#pragma unroll
            for (int m = 0; m < 4; ++m) { bf16_t* rowp = O + (size_t)(row0 + ai * HALF + m * 16) * ldc + col0;
#pragma unroll
                for (int bj = 0; bj < 2; ++bj) { const f32x4 v0 = acc[ai][bj][m][0], v1 = acc[ai][bj][m][1];
                    u32x4 w; w.x = cvt_pk_bf16(v0[0], v0[1]); w.y = cvt_pk_bf16(v0[2], v0[3]); w.z = cvt_pk_bf16(v1[0], v1[1]); w.w = cvt_pk_bf16(v1[2], v1[3]);
                    *(u32x4*)(rowp + bj * HALF) = w; } } }
    }
};
struct EpiSwiGlu {
    static constexpr bool PERM = true, AFTER_DRAIN = false;
    bf16_t* O; int ldc;
    __device__ __forceinline__ void operator()(const f32x4 (&acc)[2][2][4][2], const Unit& u, int wr, int wc, int fr, int fq) const {
        const int row0 = u.pm * BM + wr * 64 + fr, col0 = u.pn * HALF + wc * 32 + 8 * fq;
#pragma unroll
        for (int ai = 0; ai < 2; ++ai) { if (u.hm == 2 - ai) continue;
#pragma unroll
            for (int m = 0; m < 4; ++m) { bf16_t* rowp = O + (size_t)(row0 + ai * HALF + m * 16) * ldc + col0;
                const f32x4 g0 = acc[ai][0][m][0], g1 = acc[ai][0][m][1], u0 = acc[ai][1][m][0], u1 = acc[ai][1][m][1];
                const f32x2 a = silu_mul2((f32x2){g0[0], g0[1]}, (f32x2){u0[0], u0[1]}), b = silu_mul2((f32x2){g0[2], g0[3]}, (f32x2){u0[2], u0[3]});
                const f32x2 c = silu_mul2((f32x2){g1[0], g1[1]}, (f32x2){u1[0], u1[1]}), d = silu_mul2((f32x2){g1[2], g1[3]}, (f32x2){u1[2], u1[3]});
                u32x4 w; w.x = cvt_pk_bf16(a.x, a.y); w.y = cvt_pk_bf16(b.x, b.y); w.z = cvt_pk_bf16(c.x, c.y); w.w = cvt_pk_bf16(d.x, d.y);
                *(u32x4*)rowp = w; } }
    }
};

template <int N, int K, int LDA, int LDB, bool SPLIT = false, bool TAIL = false, class Epi>
__device__ __forceinline__ void gemm_phase(PG8_LAS unsigned char* lds, const bf16_t* gA, const bf16_t* gBt, int M, int G, int cid, const Epi& E, int wave_s, int Mextra = 0) {
    const int tid_ = hw_tid(wave_s);
    asm volatile("" : "+s"(G), "+s"(cid));
    const int tid = tid_, wid = __builtin_amdgcn_readfirstlane(tid >> 6), lane = tid & 63, wr = wid >> 2, wc = wid & 3, fr = lane & 15, fq = lane >> 4;
    constexpr int nt_full = K / BK, nt_q = K / 4 / BK;
    static_assert(!SPLIT || (K % 512 == 0 && (K / 4) >= 256 && nt_q % 2 == 0), "split-K shape");
    static_assert(N % 256 == 0 && K % 128 == 0 && K >= 256, "gemm shape");
    static_assert(!(SPLIT && TAIL), "one order");
    typename std::conditional<SPLIT, SplitOrder, typename std::conditional<TAIL, TailOrder, StaticOrder>::type>::type S;
    if constexpr (SPLIT) S.init(M, Mextra, N, K, G, cid); else S.init(M, N, G, cid);
    unsigned voffA[2], voffB[2];
#pragma unroll
    for (int i = 0; i < 2; ++i) { int R, C; stage_rc(tid * 16 + i * 8192, R, C); const int Rb = Epi::PERM ? ((R & ~31) + perm32(R & 31)) : R;
        voffA[i] = (unsigned)(R * LDA + C) * 2u; voffB[i] = (unsigned)(Rb * LDB + C) * 2u; }
    constexpr size_t kstep = (size_t)(BK * 2);
    constexpr size_t hstepA = (size_t)HALF * LDA * 2, hstepB = (size_t)HALF * LDB * 2;
    constexpr size_t tstepA = 2 * hstepA, tstepB = 2 * hstepB;
    const unsigned ldsw = (unsigned)wid * 1024u;
    const int aoff = lds_byte(wr * 64 + fr, fq * 8), boff = lds_byte(wc * 32 + fr, fq * 8);
#define PG8_SA(b, h) (((b) * 2 + (h)) * HTB)
#define PG8_SB(b, h) ((4 + (b) * 2 + (h)) * HTB)
#define PG8_STAGE(bufoff, gbase, voff) do { _Pragma("unroll") for (int _i = 0; _i < 2; ++_i) \
        __builtin_amdgcn_global_load_lds((const unsigned*)((const char*)(gbase) + (voff)[_i]), (PG8_LAS unsigned*)(lds + (bufoff) + ldsw + _i * 8192), 16, 0, 0); } while (0)
#define PG8_LDA(dst, b, h) do { _Pragma("unroll") for (int m = 0; m < 4; ++m) _Pragma("unroll") for (int k = 0; k < 2; ++k) dst[m][k] = *(const PG8_LAS bf16x8*)(lds + PG8_SA(b, h) + aoff + m * 2048 + k * 1024); } while (0)
#define PG8_LDB(dst, b, h) do { _Pragma("unroll") for (int n = 0; n < 2; ++n) _Pragma("unroll") for (int k = 0; k < 2; ++k) dst[n][k] = *(const PG8_LAS bf16x8*)(lds + PG8_SB(b, h) + boff + n * 2048 + k * 1024); } while (0)
#define PG8_MMA(ai, bj, At, Bt) do { __builtin_amdgcn_s_setprio(1); _Pragma("unroll") for (int m = 0; m < 4; ++m) _Pragma("unroll") for (int n = 0; n < 2; ++n) _Pragma("unroll") for (int k = 0; k < 2; ++k) \
        acc[ai][bj][m][n] = __builtin_amdgcn_mfma_f32_16x16x32_bf16(Bt[n][k], At[m][k], acc[ai][bj][m][n], 0, 0, 0); __builtin_amdgcn_s_setprio(0); } while (0)
#define PG8_WAIT_V(n) asm volatile("s_waitcnt vmcnt(" #n ")" ::: "memory")
#define PG8_WAIT_L(n) asm volatile("s_waitcnt lgkmcnt(" #n ")" ::: "memory")
#define PG8_BAR __builtin_amdgcn_s_barrier()
#define PG8_SCHED __builtin_amdgcn_sched_barrier(0)
    Unit cur, nxt; int ui = 0;
    if (!S.next(0, cur)) return;
    f32x4 acc[2][2][4][2];
#pragma unroll
    for (int a = 0; a < 2; ++a)
#pragma unroll
        for (int b = 0; b < 2; ++b)
#pragma unroll
            for (int m = 0; m < 4; ++m)
#pragma unroll
                for (int n = 0; n < 2; ++n) acc[a][b][m][n] = (f32x4){0.f, 0.f, 0.f, 0.f};
    bf16x8 At[4][2], B0[2][2], B1[2][2];
    const char* cA = (const char*)gA + (size_t)cur.pm * tstepA + (SPLIT ? cur.ko * 2 : 0); const char* cB = (const char*)gBt + (size_t)cur.pn * tstepB + (SPLIT ? cur.ko * 2 : 0);
    S.a_ready(cur);
    PG8_STAGE(PG8_SB(0, 0), cB, voffB); PG8_STAGE(PG8_SB(0, 1), cB + hstepB, voffB); PG8_STAGE(PG8_SA(0, 0), cA, voffA); PG8_STAGE(PG8_SA(0, 1), cA + hstepA, voffA);
    if (wr == 1) PG8_BAR;
    PG8_WAIT_V(2); PG8_BAR;
    PG8_STAGE(PG8_SB(1, 0), cB + kstep, voffB); PG8_STAGE(PG8_SA(1, 0), cA + kstep, voffA); PG8_STAGE(PG8_SB(1, 1), cB + hstepB + kstep, voffB);
    PG8_WAIT_V(6); PG8_BAR;
    for (;;) {
        const bool has_next = S.next(ui + 1, nxt);
        const char* nA = has_next ? (const char*)gA + (size_t)nxt.pm * tstepA + (SPLIT ? nxt.ko * 2 : 0) : cA; const char* nB = has_next ? (const char*)gBt + (size_t)nxt.pn * tstepB + (SPLIT ? nxt.ko * 2 : 0) : cB;
        const int nt = (SPLIT && cur.ks >= 0) ? nt_q : nt_full;
#define PG8_KLOOP(HM) \
        for (int t = 0; t < nt; t += 2) { \
            const bool last = (t == nt - 2); \
            const char* a1 = cA + (size_t)(t + 1) * kstep; \
            const char* a2 = last ? nA : cA + (size_t)(t + 2) * kstep; const char* b2 = last ? nB : cB + (size_t)(t + 2) * kstep; \
            const char* a3 = a2 + kstep; const char* b3 = b2 + kstep; \
            if (last && has_next) S.a_ready(nxt); \
            PG8_LDB(B0, 0, 0); PG8_LDB(B1, 0, 1); PG8_SCHED; if (HM != 2) PG8_LDA(At, 0, 0); PG8_STAGE(PG8_SA(1, 1), a1 + hstepA, voffA); \
            PG8_WAIT_V(8); PG8_WAIT_L(0); PG8_BAR; if (HM != 2) { PG8_MMA(0, 0, At, B0); PG8_MMA(0, 1, At, B1); } PG8_BAR; PG8_SCHED; \
            if (HM != 1) PG8_LDA(At, 0, 1); PG8_STAGE(PG8_SB(0, 0), b2, voffB); PG8_STAGE(PG8_SB(0, 1), b2 + hstepB, voffB); PG8_STAGE(PG8_SA(0, 0), a2, voffA); \
            PG8_WAIT_V(8); PG8_WAIT_L(0); PG8_BAR; if (HM != 1) { PG8_MMA(1, 0, At, B0); PG8_MMA(1, 1, At, B1); } PG8_BAR; PG8_SCHED; \
            PG8_LDB(B0, 1, 0); PG8_LDB(B1, 1, 1); PG8_SCHED; if (HM != 2) PG8_LDA(At, 1, 0); PG8_STAGE(PG8_SA(0, 1), a2 + hstepA, voffA); \
            PG8_WAIT_V(8); PG8_WAIT_L(0); PG8_BAR; if (HM != 2) { PG8_MMA(0, 0, At, B0); PG8_MMA(0, 1, At, B1); } PG8_BAR; PG8_SCHED; \
            if (HM != 1) PG8_LDA(At, 1, 1); PG8_STAGE(PG8_SB(1, 0), b3, voffB); PG8_STAGE(PG8_SB(1, 1), b3 + hstepB, voffB); PG8_STAGE(PG8_SA(1, 0), a3, voffA); \
            PG8_WAIT_V(8); PG8_WAIT_L(0); PG8_BAR; if (HM != 1) { PG8_MMA(1, 0, At, B0); PG8_MMA(1, 1, At, B1); } PG8_BAR; PG8_SCHED; \
        }
        if constexpr (TAIL) { if (cur.hm == 0) { PG8_KLOOP(0) } else if (cur.hm == 1) { PG8_KLOOP(1) } else { PG8_KLOOP(2) } } else { PG8_KLOOP(0) }
#undef PG8_KLOOP
        if (wr == 0) PG8_BAR;
        if constexpr (SPLIT) { if (cur.ks >= 0) E.partial(acc, cur, wr, wc, fr, fq); else E(acc, cur, wr, wc, fr, fq); } else E(acc, cur, wr, wc, fr, fq);
        if (!has_next) break;
#pragma unroll
        for (int a = 0; a < 2; ++a)
#pragma unroll
            for (int b = 0; b < 2; ++b)
#pragma unroll
                for (int m = 0; m < 4; ++m)
#pragma unroll
                    for (int n = 0; n < 2; ++n) acc[a][b][m][n] = (f32x4){0.f, 0.f, 0.f, 0.f};
        cur = nxt; cA = nA; cB = nB; ++ui;
        if (wr == 1) PG8_BAR;
    }
    PG8_WAIT_V(0);
    PG8_BAR;
#undef PG8_SA
#undef PG8_SB
#undef PG8_STAGE
#undef PG8_LDA
#undef PG8_LDB
#undef PG8_MMA
#undef PG8_WAIT_V
#undef PG8_WAIT_L
#undef PG8_BAR
#undef PG8_SCHED
}
}

constexpr int NWAVES = 8, NTHREADS = 512;
constexpr int D = 2048, NB = 8, SEQ = 4096, CTXL = 256, DEPTH = 4, DFF = 5632;
constexpr int ML = NB * SEQ, MC = NB * CTXL, MT = ML + MC;
constexpr float EPS = 1e-6f;
constexpr int GLA_N = 6400;
constexpr int MLA_CN = 1280, MLA_QN = 3072, MLA_KVN = 4096;
constexpr int SWA_N = 2560;
constexpr int BIG_LD = 8448;

constexpr size_t MiB = 1u << 20;
constexpr size_t al256(size_t x) { return (x + 255) & ~(size_t)255; }
constexpr size_t WS_CTL = 0, CTL_ZERO_BYTES = 1 * MiB;
constexpr size_t WS_MOD = 1 * MiB;
constexpr size_t WS_ROPE = WS_MOD + al256((size_t)DEPTH * 9 * 6 * D * 4);
constexpr size_t WS_WF = WS_ROPE + al256((size_t)2 * SEQ * 32 * 4);
constexpr size_t WS_RSTD = WS_WF + 2 * 131072;
constexpr size_t WS_HCTX = WS_RSTD + al256((size_t)MT * 4);
constexpr size_t WS_WFFI = WS_HCTX + al256((size_t)MC * D * 4);
constexpr size_t SZ_WFFI = (size_t)2 * DFF * D * 2;
constexpr size_t WS_WFFO = WS_WFFI + 4 * SZ_WFFI;
constexpr size_t SZ_WFFO = (size_t)D * DFF * 2;
constexpr size_t WS_WGI = WS_WFFO + 4 * SZ_WFFO;
constexpr size_t SZ_WGI = (size_t)GLA_N * D * 2;
constexpr size_t WS_WGO = WS_WGI + 2 * SZ_WGI;
constexpr size_t SZ_WDD = (size_t)D * D * 2;
constexpr size_t WS_WMI = WS_WGO + 2 * SZ_WDD;
constexpr size_t WS_WMUQ = WS_WMI + (size_t)MLA_CN * D * 2;
constexpr size_t WS_WMUKV = WS_WMUQ + (size_t)MLA_QN * 512 * 2;
constexpr size_t WS_WMO = WS_WMUKV + (size_t)MLA_KVN * 512 * 2;
constexpr size_t WS_WSI = WS_WMO + SZ_WDD;
constexpr size_t WS_WSO = WS_WSI + (size_t)SWA_N * D * 2;
constexpr size_t WS_R1 = WS_WSO + SZ_WDD;
constexpr size_t WS_R2 = WS_R1 + (size_t)MT * D * 2;
constexpr size_t WS_BIG = WS_R2 + (size_t)MT * D * 2;
constexpr size_t WS_PART = WS_BIG + (size_t)MT * BIG_LD * 2;
constexpr size_t WS_GU = WS_PART + (size_t)4 * MC * D * 4;
constexpr size_t WS_END0 = WS_GU + (size_t)MT * 32 * 4;
constexpr size_t WS_END = WS_END0 > WS_PART + (size_t)NB * 4 * 2 * 68 * 74752 ? WS_END0 : WS_PART + (size_t)NB * 4 * 2 * 68 * 74752;
constexpr int CW_BAR = 4096;

constexpr int LDS_BYTES = 147456;
constexpr int LDSCTL_OFF = 146944;

#define GAS __attribute__((address_space(1)))
#define LAS __attribute__((address_space(3)))
typedef unsigned short bf16;
typedef unsigned v4u __attribute__((ext_vector_type(4)));
typedef unsigned v2u __attribute__((ext_vector_type(2)));
typedef float f32x4 __attribute__((ext_vector_type(4)));
#define LDS_WAIT() asm volatile("s_waitcnt lgkmcnt(0)" ::: "memory")
#define VM_WAIT() asm volatile("s_waitcnt vmcnt(0)" ::: "memory")
__device__ __forceinline__ unsigned f2bf(float f) { unsigned u = __builtin_bit_cast(unsigned, f); return (u + 0x7fffu + ((u >> 16) & 1u)) >> 16; }
__device__ __forceinline__ unsigned pk2(float lo, float hi) { return f2bf(lo) | (f2bf(hi) << 16); }
__device__ __forceinline__ float bflo(unsigned w) { return __builtin_bit_cast(float, w << 16); }
__device__ __forceinline__ float bfhi(unsigned w) { return __builtin_bit_cast(float, w & 0xffff0000u); }
__device__ __forceinline__ float bf2f(bf16 b) { return __builtin_bit_cast(float, (unsigned)b << 16); }
__device__ __forceinline__ float wave_sum(float v) {
    v += __builtin_bit_cast(float, __builtin_amdgcn_update_dpp(0, __builtin_bit_cast(int, v), 0xB1, 0xF, 0xF, true));
    v += __builtin_bit_cast(float, __builtin_amdgcn_update_dpp(0, __builtin_bit_cast(int, v), 0x4E, 0xF, 0xF, true));
    v += __builtin_bit_cast(float, __builtin_amdgcn_update_dpp(0, __builtin_bit_cast(int, v), 0x141, 0xF, 0xF, true));
    v += __builtin_bit_cast(float, __builtin_amdgcn_update_dpp(0, __builtin_bit_cast(int, v), 0x140, 0xF, 0xF, true));
    v += __shfl_xor(v, 16); v += __shfl_xor(v, 32);
    return v;
}

#define XB_TMO      128
#define XB_XCNT(j)  (256  + 64 * (j))
#define XB_XSUB(j)  (1280 + 64 * (j))
#define XB_XGEN(j)  (2304 + 64 * (j))
#define XB_TOP      3328
#define XB_TOPGEN   3392
#define XCD_BAR_WORDS 3456
#define XB_SPIN_CAP (1u << 22)
__device__ __forceinline__ unsigned xb_ld(unsigned* p)              { return __hip_atomic_load(p, __ATOMIC_RELAXED, __HIP_MEMORY_SCOPE_AGENT); }
__device__ __forceinline__ unsigned xb_add(unsigned* p, unsigned v) { return __hip_atomic_fetch_add(p, v, __ATOMIC_RELAXED, __HIP_MEMORY_SCOPE_AGENT); }
__device__ __forceinline__ unsigned xb_xcc_id() { return (unsigned)__builtin_amdgcn_s_getreg((3 << 11) | 20) & 0xFu; }
#define XB_SPIN(cond, bar) do { unsigned _sp = 0; while (cond) { __builtin_amdgcn_s_sleep(1); \
    if ((++_sp & 255u) == 0u) { if (xb_ld(&(bar)[XB_TMO])) break; if (_sp > XB_SPIN_CAP) { atomicAdd(&(bar)[XB_TMO], 1u); break; } } } } while (0)
struct XcdBarrier { unsigned* bar; unsigned x; volatile LAS unsigned* st; };
__device__ __forceinline__ XcdBarrier xcd_barrier_post(unsigned* bar, volatile LAS unsigned* st, bool leader) {
    XcdBarrier b; b.bar = bar; b.x = xb_xcc_id(); b.st = st;
    if (leader) (void)xb_add(&bar[XB_XCNT(b.x)], 1u);
    return b;
}
__device__ __forceinline__ void xcd_barrier_complete(unsigned* bar, unsigned x, unsigned& nloc, unsigned& nx) {
    const unsigned G = gridDim.x * gridDim.y * gridDim.z;
    unsigned sum, cnt, mine, sp = 0u;
    for (;;) {
        sum = 0u; cnt = 0u; mine = 0u;
#pragma unroll
        for (unsigned j = 0; j < 16; ++j) { const unsigned c = xb_ld(&bar[XB_XCNT(j)]); sum += c; cnt += (c > 0u) ? 1u : 0u; mine = (j == x) ? c : mine; }
        if (sum == G) break;
        __builtin_amdgcn_s_sleep(1);
        if ((++sp & 255u) == 0u) { if (xb_ld(&bar[XB_TMO])) break; if (sp > XB_SPIN_CAP) { atomicAdd(&bar[XB_TMO], 1u); break; } }
    }
    nloc = mine > 0u ? mine : 1u; nx = cnt > 0u ? cnt : 1u;
}
__device__ __forceinline__ void xcd_barrier(const XcdBarrier& b, bool leader) {
    asm volatile("s_waitcnt vmcnt(0)" ::: "memory");
    __syncthreads();
    if (leader) {
        unsigned* bar = b.bar;
        __builtin_amdgcn_s_waitcnt(0);
        unsigned nloc = b.st[0], nx = b.st[1];
        if (nloc == 0u) { xcd_barrier_complete(bar, b.x, nloc, nx); b.st[0] = nloc; b.st[1] = nx; }
        const unsigned old = xb_add(&bar[XB_XSUB(b.x)], 1u);
        const unsigned gen = old / nloc;
        if (old + 1u == (gen + 1u) * nloc) {
            __builtin_amdgcn_fence(__ATOMIC_RELEASE, "agent");
            asm volatile("s_waitcnt vmcnt(0)" ::: "memory");
            const unsigned og = xb_add(&bar[XB_TOP], 1u);
            const unsigned tg = og / nx;
            if (og + 1u == (tg + 1u) * nx) xb_add(&bar[XB_TOPGEN], 1u);
            else XB_SPIN(xb_ld(&bar[XB_TOPGEN]) == tg, bar);
            __builtin_amdgcn_fence(__ATOMIC_ACQUIRE, "agent");
            xb_add(&bar[XB_XGEN(b.x)], 1u);
            asm volatile("s_waitcnt vmcnt(0)" ::: "memory");
        } else {
            XB_SPIN(xb_ld(&bar[XB_XGEN(b.x)]) == gen, bar);
            __builtin_amdgcn_fence(__ATOMIC_ACQUIRE, "agent");
            asm volatile("s_waitcnt vmcnt(0)" ::: "memory");
        }
    }
    __syncthreads();
}

struct Args { const float* in[24]; float* out; unsigned char* ws; int ph_lo, ph_hi; };
struct Frame {
    LAS unsigned char* lds;
    int tid, lane, wave, G, bid, vb;
};
__device__ __forceinline__ Frame relaunder(const Frame& F0) {
    Frame F = F0; int wv = F0.wave; asm volatile("" : "+s"(wv)); F.wave = wv; F.lane = hw_lane(); F.tid = wv * 64 + F.lane;
    int g = F0.G, b = F0.bid; asm volatile("" : "+s"(g), "+s"(b)); F.G = g; F.bid = b; F.vb = (g % 8 == 0) ? (b % 8) * (g / 8) + b / 8 : b; return F;
}
typedef __attribute__((address_space(1))) unsigned char gbyte;
__device__ __forceinline__ const float* inp(const Args& P, int i) { const float* p = P.in[i]; asm volatile("" : "+s"(p)); return p; }
__device__ __forceinline__ gbyte* wsp(const Args& P) { unsigned char* p = P.ws; asm volatile("" : "+s"(p)); return (gbyte*)p; }
enum { I_X = 0, I_C, I_CTX, I_CCTX, I_WADA, I_BADA, I_GNORM, I_WFFI, I_WFFO, I_GWIN, I_GWGD, I_GWGU, I_GBG, I_GGH, I_GWO,
       I_MWIN, I_MGQ, I_MWUQ, I_MGKV, I_MWUKV, I_MWO, I_SWIN, I_SSINK, I_SWO };

__device__ __forceinline__ bf16* hrow_b(const Frame& F, const Args& P, int row) { return row < ML ? (bf16*)((gbyte*)P.out + (size_t)row * (D * 4) + D * 2) : (bf16*)(wsp(P) + WS_HCTX + (size_t)(row - ML) * (D * 4) + D * 2); }
__device__ __forceinline__ const float* hrow_in(const Frame& F, const Args& P, int row) { return row < ML ? inp(P, I_X) + (size_t)row * D : inp(P, I_CTX) + (size_t)(row - ML) * D; }
__device__ __forceinline__ int row_cond(int row) { return row < ML ? (row >> 12) : 8; }
__device__ __forceinline__ const float* modp(const Frame& F, const Args& P, int L, int r, int slot) { return (const float*)(wsp(P) + WS_MOD) + ((size_t)(L * 9 + r) * 6 + slot) * D; }

__device__ __forceinline__ void mod_item(const Frame& F, const Args& P, int it) {
    const int L = it / 192, col0 = (it % 192) * 64;
    LAS float* cs = (LAS float*)F.lds;
    __syncthreads();
    for (int i = F.tid; i < 9 * D; i += NTHREADS) { const int r = i / D, k = i % D; const float c = (r < 8) ? inp(P, I_C)[r * D + k] : inp(P, I_CCTX)[k]; cs[k * 12 + r] = c / (1.0f + __expf(-c)); }
    __syncthreads();
    const int cg = F.tid & 15, kg = F.tid >> 4;
    const float* W = inp(P, I_WADA) + (size_t)L * D * (6 * D) + col0 + 4 * cg;
    float acc[9][4];
#pragma unroll
    for (int r = 0; r < 9; ++r) { acc[r][0] = 0.f; acc[r][1] = 0.f; acc[r][2] = 0.f; acc[r][3] = 0.f; }
#pragma unroll 16
    for (int kk = 0; kk < 64; ++kk) { const int k = kg * 64 + kk;
        const f32x4 w = *(const f32x4*)(W + (size_t)k * (6 * D));
        const f32x4 s0 = *(const LAS f32x4*)(cs + k * 12), s1 = *(const LAS f32x4*)(cs + k * 12 + 4); const float s8 = cs[k * 12 + 8];
#pragma unroll
        for (int j = 0; j < 4; ++j) { acc[0][j] += s0[0] * w[j]; acc[1][j] += s0[1] * w[j]; acc[2][j] += s0[2] * w[j]; acc[3][j] += s0[3] * w[j];
            acc[4][j] += s1[0] * w[j]; acc[5][j] += s1[1] * w[j]; acc[6][j] += s1[2] * w[j]; acc[7][j] += s1[3] * w[j]; acc[8][j] += s8 * w[j]; } }
    __syncthreads();
    LAS float* red = (LAS float*)F.lds;
#pragma unroll
    for (int r = 0; r < 9; ++r) *(LAS f32x4*)(red + (kg * 9 + r) * 64 + 4 * cg) = (f32x4){acc[r][0], acc[r][1], acc[r][2], acc[r][3]};
    __syncthreads();
    for (int o = F.tid; o < 9 * 64; o += NTHREADS) { const int r = o / 64, c = o % 64; float s = 0.f;
        for (int g = 0; g < 32; ++g) s += red[(g * 9 + r) * 64 + c];
        ((float*)(wsp(P) + WS_MOD))[(size_t)(L * 9 + r) * (6 * D) + col0 + c] = s + inp(P, I_BADA)[L * (6 * D) + col0 + c]; }
}
__device__ __forceinline__ void rope_item(const Frame& F, const Args& P, int it) {
    const int e = it * NTHREADS + F.tid;
    const int t = e >> 5, f = e & 31; const int pos = (f < 16) ? (t >> 6) : (t & 63);
    const float inv = powf(10000.0f, -(float)(f & 15) / 16.0f); const float ang = (float)pos * inv;
    float* rt = (float*)(wsp(P) + WS_ROPE); rt[e] = cosf(ang); rt[SEQ * 32 + e] = sinf(ang);
}
template <int MODE>
__device__ __forceinline__ void cvt_item(const float* W, int ldw, int k0, int srccol0, bf16* WT, int ldt, int dstrow0, float scale, const float* kscale, LAS float* scr, int lane, const float* gu) {
    if (MODE == 2) {
#pragma unroll 8
        for (int kk = 0; kk < 64; ++kk) scr[kk * 65 + lane] = (lane < 32) ? W[((size_t)(lane >> 4) * D + k0 + kk) * 16 + (lane & 15)] : 0.f;
    } else if (MODE == 1) {
#pragma unroll 8
        for (int kk = 0; kk < 64; ++kk) scr[kk * 65 + lane] = 0.f;
    } else {
        const float* wp = W + (size_t)k0 * ldw + srccol0 + lane;
        float v[64];
#pragma unroll
        for (int kk = 0; kk < 64; ++kk) v[kk] = wp[(size_t)kk * ldw];
        if (kscale) {
#pragma unroll
            for (int kk = 0; kk < 64; ++kk) v[kk] *= kscale[k0 + kk];
        }
#pragma unroll
        for (int kk = 0; kk < 64; ++kk) scr[kk * 65 + lane] = v[kk] * scale;
    }
    LDS_WAIT(); asm volatile("" ::: "memory");
    const int c = lane & 7;
#pragma unroll
    for (int j = 0; j < 8; ++j) { const int nn = (lane >> 3) + 8 * j; const LAS float* sp = scr + (8 * c) * 65 + nn;
        v4u o; o.x = pk2(sp[0 * 65], sp[1 * 65]); o.y = pk2(sp[2 * 65], sp[3 * 65]); o.z = pk2(sp[4 * 65], sp[5 * 65]); o.w = pk2(sp[6 * 65], sp[7 * 65]);
        *(v4u*)(WT + (size_t)(dstrow0 + nn) * ldt + k0 + 8 * c) = o; }
    LDS_WAIT(); asm volatile("" ::: "memory");
}
__device__ __forceinline__ void prologue(const Frame& F0, const Args& P) {
    const Frame F = relaunder(F0);
    for (int it = F.bid; it < 768 + 256 + 32; it += F.G) {
        if (it < 768) mod_item(F, P, it); else if (it < 1024) rope_item(F, P, it - 768);
        else { const int f = (it - 1024) * NTHREADS + F.tid, jl = f >> 13, ff = f & 8191;
            const int dt = ff >> 6, l = ff & 63, m = l & 15, q = l >> 4, dir = dt >> 6, c = (dt & 63) * 16 + m; const float* gu = inp(P, I_GWGU) + (size_t)jl * 2 * 16 * 1024;
            float v[8];
#pragma unroll
            for (int jj = 0; jj < 8; ++jj) { const int k = 8 * q + jj; v[jj] = ((k >> 4) == dir) ? gu[(size_t)(dir * 16 + (k & 15)) * 1024 + c] : 0.f; }
            *(v4u*)(wsp(P) + WS_WF + (size_t)f * 16) = (v4u){pk2(v[0], v[1]), pk2(v[2], v[3]), pk2(v[4], v[5]), pk2(v[6], v[7])}; }
    }
    __syncthreads();
    LAS float* scr = (LAS float*)(F.lds + F.wave * 16640);
    const int gw = F.bid * NWAVES + F.wave, NGW = F.G * NWAVES;
    constexpr int I_FFI = 32 * 176, I_FFO = 88 * 32, I_GI = 32 * 100, I_DD = 32 * 32, I_MI = 32 * 20, I_MUQ = 8 * 48, I_MUKV = 8 * 64, I_SI = 32 * 40;
    constexpr int NITEMS = 4 * I_FFI + 4 * I_FFO + 2 * I_GI + 2 * I_DD + I_MI + I_MUQ + I_MUKV + I_DD + I_SI + I_DD;
    for (int it = gw; it < NITEMS; it += NGW) {
        int r = it;
        const float* W = nullptr; const float* ks = nullptr; const float* gu = nullptr; bf16* WT; int ldw = 0, k0, src = 0, ldt, drow; float sc = 1.f; int mode = 0;
        if (r < 4 * I_FFI) { const int L = r / I_FFI; r %= I_FFI; const int kb = r / 176, nb = r % 176, p0 = nb * 64, pn = p0 >> 8, j = p0 & 255;
            src = (j < 128) ? pn * 128 + j : DFF + pn * 128 + (j - 128);
            W = inp(P, I_WFFI) + (size_t)L * D * 2 * DFF; ldw = 2 * DFF; k0 = kb * 64; WT = (bf16*)(wsp(P) + WS_WFFI + L * SZ_WFFI); ldt = D; drow = p0; }
        else if ((r -= 4 * I_FFI) < 4 * I_FFO) { const int L = r / I_FFO; r %= I_FFO; const int kb = r / 32, nb = r % 32;
            W = inp(P, I_WFFO) + (size_t)L * DFF * D; ldw = D; k0 = kb * 64; src = nb * 64; WT = (bf16*)(wsp(P) + WS_WFFO + L * SZ_WFFO); ldt = DFF; drow = nb * 64; }
        else if ((r -= 4 * I_FFO) < 2 * I_GI) { const int j = r / I_GI; r %= I_GI; const int kb = r / 100, nb = r % 100, p0 = nb * 64; WT = (bf16*)(wsp(P) + WS_WGI + j * SZ_WGI); ldt = D; drow = p0; k0 = kb * 64;
            if (p0 < 6144) { W = inp(P, I_GWIN) + (size_t)j * D * 6144; ldw = 6144; src = p0; sc = p0 < 1024 ? 0.0625f : 1.f; }
            else if (p0 == 6144) { mode = 2; W = inp(P, I_GWGD) + (size_t)j * 2 * D * 16; }
            else mode = 1; }
        else if ((r -= 2 * I_GI) < 2 * I_DD) { const int j = r / I_DD; r %= I_DD; const int kb = r / 32, nb = r % 32;
            W = inp(P, I_GWO) + (size_t)j * D * D; ldw = D; k0 = kb * 64; src = nb * 64; WT = (bf16*)(wsp(P) + WS_WGO + j * SZ_WDD); ldt = D; drow = nb * 64; }
        else if ((r -= 2 * I_DD) < I_MI) { const int kb = r / 20, nb = r % 20; k0 = kb * 64; WT = (bf16*)(wsp(P) + WS_WMI); ldt = D; drow = nb * 64;
            if (nb < 17) { W = inp(P, I_MWIN); ldw = 1088; src = nb * 64; } else mode = 1; }
        else if ((r -= I_MI) < I_MUQ) { const int kb = r / 48, nb = r % 48; W = inp(P, I_MWUQ); ldw = MLA_QN; k0 = kb * 64; src = nb * 64; WT = (bf16*)(wsp(P) + WS_WMUQ); ldt = 512; drow = nb * 64; ks = inp(P, I_MGQ); }
        else if ((r -= I_MUQ) < I_MUKV) { const int kb = r / 64, nb = r % 64; W = inp(P, I_MWUKV); ldw = MLA_KVN; k0 = kb * 64; src = nb * 64; WT = (bf16*)(wsp(P) + WS_WMUKV); ldt = 512; drow = nb * 64; ks = inp(P, I_MGKV); }
        else if ((r -= I_MUKV) < I_DD) { const int kb = r / 32, nb = r % 32; W = inp(P, I_MWO); ldw = D; k0 = kb * 64; src = nb * 64; WT = (bf16*)(wsp(P) + WS_WMO); ldt = D; drow = nb * 64; }
        else if ((r -= I_DD) < I_SI) { const int kb = r / 40, nb = r % 40; W = inp(P, I_SWIN); ldw = SWA_N; k0 = kb * 64; src = nb * 64; WT = (bf16*)(wsp(P) + WS_WSI); ldt = D; drow = nb * 64; }
        else { r -= I_SI; const int kb = r / 32, nb = r % 32; W = inp(P, I_SWO); ldw = D; k0 = kb * 64; src = nb * 64; WT = (bf16*)(wsp(P) + WS_WSO); ldt = D; drow = nb * 64; }
        if (mode == 2) cvt_item<2>(W, 16, k0, src, WT, ldt, drow, 1.f, nullptr, scr, F.lane, gu);
        else if (mode == 1) cvt_item<1>(nullptr, 0, k0, 0, WT, ldt, drow, 1.f, nullptr, scr, F.lane, nullptr);
        else cvt_item<0>(W, ldw, k0, src, WT, ldt, drow, sc, ks, scr, F.lane, nullptr);
    }
}

template <int NR>
__device__ __forceinline__ void row_stage01(const Frame& F, const Args& P, int L, int stage, int row0, int rstep) {
    const LAS float* V0 = (const LAS float*)F.lds; const LAS float* V2 = V0 + 2 * D; const LAS float* V3 = V0 + 3 * D;
    bf16* Y = (bf16*)(wsp(P) + WS_R2); bf16* A = (bf16*)(wsp(P) + WS_R1); float* RS = (float*)(wsp(P) + WS_RSTD);
    f32x4 h[NR][8], y[NR][8];
#pragma unroll
    for (int n = 0; n < NR; ++n) { const int row = row0 + n * rstep;
        if (stage == 0) { const float* hin = hrow_in(F, P, row); bf16* hb = hrow_b(F, P, row);
#pragma unroll
            for (int j = 0; j < 8; ++j) { h[n][j] = ((const f32x4*)hin)[F.lane + 64 * j]; v2u w; w.x = pk2(h[n][j][0], h[n][j][1]); w.y = pk2(h[n][j][2], h[n][j][3]);
                ((v2u*)hb)[F.lane + 64 * j] = w; } }
        else { const bf16* hb = hrow_b(F, P, row);
#pragma unroll
            for (int j = 0; j < 8; ++j) { const v2u w = ((const v2u*)hb)[F.lane + 64 * j]; h[n][j] = (f32x4){bflo(w.x), bfhi(w.x), bflo(w.y), bfhi(w.y)}; } }
        if (stage == 1) {
#pragma unroll
            for (int j = 0; j < 8; ++j) {
                if (row < ML) { const v2u w = ((const v2u*)(Y + (size_t)row * D))[F.lane + 64 * j]; y[n][j] = (f32x4){bflo(w.x), bfhi(w.x), bflo(w.y), bfhi(w.y)}; }
                else { const f32x4* pp = (const f32x4*)((const float*)(wsp(P) + WS_PART) + (size_t)(row - ML) * D) + F.lane + 64 * j;
                    y[n][j] = (pp[0] + pp[(size_t)MC * D / 4]) + (pp[(size_t)2 * MC * D / 4] + pp[(size_t)3 * MC * D / 4]); } }
        }
    }
#pragma unroll
    for (int n = 0; n < NR; ++n) { const int row = row0 + n * rstep;
        if (stage == 1) {
            if (row >= ML) {
#pragma unroll
                for (int j = 0; j < 8; ++j) { v2u w; w.x = pk2(y[n][j][0], y[n][j][1]); w.y = pk2(y[n][j][2], y[n][j][3]); ((v2u*)(Y + (size_t)row * D))[F.lane + 64 * j] = w;
                    y[n][j] = (f32x4){bflo(w.x), bfhi(w.x), bflo(w.y), bfhi(w.y)}; }
            }
            float ss = 0.f;
#pragma unroll
            for (int j = 0; j < 8; ++j) ss += (y[n][j][0] * y[n][j][0] + y[n][j][1] * y[n][j][1]) + (y[n][j][2] * y[n][j][2] + y[n][j][3] * y[n][j][3]);
            const float rstd = __builtin_amdgcn_rsqf(wave_sum(ss) * (1.0f / D) + EPS);
            if (F.lane == 0) RS[row] = rstd;
#pragma unroll
            for (int j = 0; j < 8; ++j) { const f32x4 w0 = *(const LAS f32x4*)(V0 + 4 * (F.lane + 64 * j)); h[n][j] = h[n][j] + w0 * (y[n][j] * rstd); }
        }
        float ss = 0.f;
#pragma unroll
        for (int j = 0; j < 8; ++j) ss += (h[n][j][0] * h[n][j][0] + h[n][j][1] * h[n][j][1]) + (h[n][j][2] * h[n][j][2] + h[n][j][3] * h[n][j][3]);
        const float rstd = __builtin_amdgcn_rsqf(wave_sum(ss) * (1.0f / D) + EPS);
#pragma unroll
        for (int j = 0; j < 8; ++j) { const f32x4 w1 = *(const LAS f32x4*)(V2 + 4 * (F.lane + 64 * j)), w2 = *(const LAS f32x4*)(V3 + 4 * (F.lane + 64 * j));
            const f32x4 a = (h[n][j] * rstd) * w1 + w2; v2u w; w.x = pk2(a[0], a[1]); w.y = pk2(a[2], a[3]);
            ((v2u*)(A + (size_t)row * D))[F.lane + 64 * j] = w; }
    }
}
template <int NR>
__device__ __forceinline__ void row_stage2(const Frame& F, const Args& P, int L, bool want_a, int row0, int rstep) {
    const LAS float* V0 = (const LAS float*)F.lds; const LAS float* V1 = V0 + D; const LAS float* V2 = V0 + 2 * D; const LAS float* V3 = V0 + 3 * D;
    const bf16* Y = (const bf16*)(wsp(P) + WS_R2); bf16* FA = (bf16*)(wsp(P) + WS_R1); const float* RS = (const float*)(wsp(P) + WS_RSTD);
    f32x4 h[NR][8], f[NR][8]; v2u yp[NR][8]; float rsy[NR];
#pragma unroll
    for (int n = 0; n < NR; ++n) { const int row = row0 + n * rstep;
        { const bf16* hb = hrow_b(F, P, row);
#pragma unroll
            for (int j = 0; j < 8; ++j) { const v2u w = ((const v2u*)hb)[F.lane + 64 * j]; h[n][j] = (f32x4){bflo(w.x), bfhi(w.x), bflo(w.y), bfhi(w.y)}; } }
#pragma unroll
        for (int j = 0; j < 8; ++j) yp[n][j] = ((const v2u*)(Y + (size_t)row * D))[F.lane + 64 * j];
        rsy[n] = RS[row];
#pragma unroll
        for (int j = 0; j < 8; ++j) {
            if (row < ML) { const v2u w = ((const v2u*)(FA + (size_t)row * D))[F.lane + 64 * j]; f[n][j] = (f32x4){bflo(w.x), bfhi(w.x), bflo(w.y), bfhi(w.y)}; }
            else { const f32x4* pp = (const f32x4*)((const float*)(wsp(P) + WS_PART) + (size_t)(row - ML) * D) + F.lane + 64 * j;
                f[n][j] = (pp[0] + pp[(size_t)MC * D / 4]) + (pp[(size_t)2 * MC * D / 4] + pp[(size_t)3 * MC * D / 4]); } }
    }
    const bool last = (L == DEPTH - 1);
    if (last) asm volatile("s_waitcnt vmcnt(0)" ::: "memory");
#pragma unroll
    for (int n = 0; n < NR; ++n) { const int row = row0 + n * rstep;
        float ss = 0.f;
#pragma unroll
        for (int j = 0; j < 8; ++j) ss += (f[n][j][0] * f[n][j][0] + f[n][j][1] * f[n][j][1]) + (f[n][j][2] * f[n][j][2] + f[n][j][3] * f[n][j][3]);
        const float rstd_f = __builtin_amdgcn_rsqf(wave_sum(ss) * (1.0f / D) + EPS);
        float* hout = (float*)((gbyte*)P.out + (size_t)row * (D * 4)); bf16* hbo = hrow_b(F, P, row);
#pragma unroll
        for (int j = 0; j < 8; ++j) { const f32x4 w0 = *(const LAS f32x4*)(V0 + 4 * (F.lane + 64 * j)), w1 = *(const LAS f32x4*)(V1 + 4 * (F.lane + 64 * j));
            const f32x4 yv = (f32x4){bflo(yp[n][j].x), bfhi(yp[n][j].x), bflo(yp[n][j].y), bfhi(yp[n][j].y)};
            h[n][j] = h[n][j] + w0 * (yv * rsy[n]);
            h[n][j] = h[n][j] + w1 * (f[n][j] * rstd_f);
            if (last) ((f32x4*)hout)[F.lane + 64 * j] = h[n][j];
            else { v2u w; w.x = pk2(h[n][j][0], h[n][j][1]); w.y = pk2(h[n][j][2], h[n][j][3]); ((v2u*)hbo)[F.lane + 64 * j] = w; } }
        if (want_a) {
            float s2 = 0.f;
#pragma unroll
            for (int j = 0; j < 8; ++j) s2 += (h[n][j][0] * h[n][j][0] + h[n][j][1] * h[n][j][1]) + (h[n][j][2] * h[n][j][2] + h[n][j][3] * h[n][j][3]);
            const float rstd = __builtin_amdgcn_rsqf(wave_sum(s2) * (1.0f / D) + EPS);
#pragma unroll
            for (int j = 0; j < 8; ++j) { const f32x4 w2 = *(const LAS f32x4*)(V2 + 4 * (F.lane + 64 * j)), w3 = *(const LAS f32x4*)(V3 + 4 * (F.lane + 64 * j));
                const f32x4 a = (h[n][j] * rstd) * w2 + w3; v2u w; w.x = pk2(a[0], a[1]); w.y = pk2(a[2], a[3]);
                ((v2u*)(FA + (size_t)row * D))[F.lane + 64 * j] = w; }
        }
    }
}
struct RowRaw { v2u h[8]; v2u y[8]; v2u f[8]; float rsy; };
__device__ __forceinline__ f32x4 unpk4(const v2u w) { return (f32x4){bflo(w.x), bfhi(w.x), bflo(w.y), bfhi(w.y)}; }
template <int STAGE>
__device__ __forceinline__ void rowraw_load(RowRaw& R, const Frame& F, const Args& P, int row) {
    const bf16* hb = hrow_b(F, P, row); const bf16* Y = (const bf16*)(wsp(P) + WS_R2);
#pragma unroll
    for (int j = 0; j < 8; ++j) R.h[j] = ((const v2u*)hb)[F.lane + 64 * j];
#pragma unroll
    for (int j = 0; j < 8; ++j) R.y[j] = ((const v2u*)(Y + (size_t)row * D))[F.lane + 64 * j];
    if (STAGE == 2) { const bf16* FA = (const bf16*)(wsp(P) + WS_R1);
#pragma unroll
        for (int j = 0; j < 8; ++j) R.f[j] = ((const v2u*)(FA + (size_t)row * D))[F.lane + 64 * j];
        R.rsy = ((const float*)(wsp(P) + WS_RSTD))[row]; }
}
template <int STAGE, bool LAST>
__device__ __forceinline__ void rowraw_compute(const RowRaw& cur, const Frame& F, const Args& P, int row) {
    const LAS float* V0 = (const LAS float*)F.lds; const LAS float* V1 = V0 + D; const LAS float* V2 = V0 + 2 * D; const LAS float* V3 = V0 + 3 * D;
    bf16* A = (bf16*)(wsp(P) + WS_R1); float* RS = (float*)(wsp(P) + WS_RSTD);
    if (LAST) asm volatile("s_waitcnt vmcnt(0)" ::: "memory");
    f32x4 h[8];
#pragma unroll
    for (int j = 0; j < 8; ++j) h[j] = unpk4(cur.h[j]);
    if (STAGE == 1) {
        float ss = 0.f;
#pragma unroll
        for (int j = 0; j < 8; ++j) { const f32x4 y = unpk4(cur.y[j]); ss += (y[0] * y[0] + y[1] * y[1]) + (y[2] * y[2] + y[3] * y[3]); }
        const float rstd_y = __builtin_amdgcn_rsqf(wave_sum(ss) * (1.0f / D) + EPS);
        if (F.lane == 0) RS[row] = rstd_y;
#pragma unroll
        for (int j = 0; j < 8; ++j) { const f32x4 w0 = *(const LAS f32x4*)(V0 + 4 * (F.lane + 64 * j)); h[j] = h[j] + w0 * (unpk4(cur.y[j]) * rstd_y); }
    } else {
        float ss = 0.f;
#pragma unroll
        for (int j = 0; j < 8; ++j) { const f32x4 f = unpk4(cur.f[j]); ss += (f[0] * f[0] + f[1] * f[1]) + (f[2] * f[2] + f[3] * f[3]); }
        const float rstd_f = __builtin_amdgcn_rsqf(wave_sum(ss) * (1.0f / D) + EPS);
        float* hout = (float*)((gbyte*)P.out + (size_t)row * (D * 4)); bf16* hbo = hrow_b(F, P, row);
#pragma unroll
        for (int j = 0; j < 8; ++j) { const f32x4 w0 = *(const LAS f32x4*)(V0 + 4 * (F.lane + 64 * j)), w1 = *(const LAS f32x4*)(V1 + 4 * (F.lane + 64 * j));
            h[j] = h[j] + w0 * (unpk4(cur.y[j]) * cur.rsy);
            h[j] = h[j] + w1 * (unpk4(cur.f[j]) * rstd_f);
            if (LAST) ((f32x4*)hout)[F.lane + 64 * j] = h[j];
            else { v2u w; w.x = pk2(h[j][0], h[j][1]); w.y = pk2(h[j][2], h[j][3]); ((v2u*)hbo)[F.lane + 64 * j] = w; } }
    }
    if (!LAST) {
        float s2 = 0.f;
#pragma unroll
        for (int j = 0; j < 8; ++j) s2 += (h[j][0] * h[j][0] + h[j][1] * h[j][1]) + (h[j][2] * h[j][2] + h[j][3] * h[j][3]);
        const float rstd = __builtin_amdgcn_rsqf(wave_sum(s2) * (1.0f / D) + EPS);
#pragma unroll
        for (int j = 0; j < 8; ++j) { const f32x4 w2 = *(const LAS f32x4*)(V2 + 4 * (F.lane + 64 * j)), w3 = *(const LAS f32x4*)(V3 + 4 * (F.lane + 64 * j));
            const f32x4 a = (h[j] * rstd) * w2 + w3; v2u w; w.x = pk2(a[0], a[1]); w.y = pk2(a[2], a[3]);
            ((v2u*)(A + (size_t)row * D))[F.lane + 64 * j] = w; }
    }
}
template <int STAGE, bool LAST>
__device__ __forceinline__ void row_lat_pipe(const Frame& F, const Args& P, int row0) {
    RowRaw ra, rb;
    rowraw_load<STAGE>(ra, F, P, row0);
    for (int k = 0; k < 7; ++k) { const int row = row0 + 16 * k;
        rowraw_load<STAGE>(rb, F, P, row + 8);  rowraw_compute<STAGE, LAST>(ra, F, P, row);
        rowraw_load<STAGE>(ra, F, P, row + 16); rowraw_compute<STAGE, LAST>(rb, F, P, row + 8); }
    rowraw_load<STAGE>(rb, F, P, row0 + 120); rowraw_compute<STAGE, LAST>(ra, F, P, row0 + 112);
    rowraw_compute<STAGE, LAST>(rb, F, P, row0 + 120);
}
struct RowRaw0 { f32x4 h[8]; };
__device__ __forceinline__ void rowraw0_load(RowRaw0& R, const Frame& F, const Args& P, int row) {
    const float* hin = hrow_in(F, P, row);
#pragma unroll
    for (int j = 0; j < 8; ++j) R.h[j] = ((const f32x4*)hin)[F.lane + 64 * j];
}
__device__ __forceinline__ void rowraw0_compute(const RowRaw0& cur, const Frame& F, const Args& P, int row) {
    const LAS float* V2 = (const LAS float*)F.lds + 2 * D; const LAS float* V3 = (const LAS float*)F.lds + 3 * D;
    bf16* A = (bf16*)(wsp(P) + WS_R1); bf16* hb = hrow_b(F, P, row);
    float ss = 0.f;
#pragma unroll
    for (int j = 0; j < 8; ++j) { const f32x4 h = cur.h[j]; v2u w; w.x = pk2(h[0], h[1]); w.y = pk2(h[2], h[3]); ((v2u*)hb)[F.lane + 64 * j] = w;
        ss += (h[0] * h[0] + h[1] * h[1]) + (h[2] * h[2] + h[3] * h[3]); }
    const float rstd = __builtin_amdgcn_rsqf(wave_sum(ss) * (1.0f / D) + EPS);
#pragma unroll
    for (int j = 0; j < 8; ++j) { const f32x4 w2 = *(const LAS f32x4*)(V2 + 4 * (F.lane + 64 * j)), w3 = *(const LAS f32x4*)(V3 + 4 * (F.lane + 64 * j));
        const f32x4 a = (cur.h[j] * rstd) * w2 + w3; v2u w; w.x = pk2(a[0], a[1]); w.y = pk2(a[2], a[3]);
        ((v2u*)(A + (size_t)row * D))[F.lane + 64 * j] = w; }
}
__device__ __forceinline__ void row_lat_pipe0(const Frame& F, const Args& P, int row0) {
    RowRaw0 ra, rb;
    rowraw0_load(ra, F, P, row0);
    for (int k = 0; k < 7; ++k) { const int row = row0 + 16 * k;
        rowraw0_load(rb, F, P, row + 8);  rowraw0_compute(ra, F, P, row);
        rowraw0_load(ra, F, P, row + 16); rowraw0_compute(rb, F, P, row + 8); }
    rowraw0_load(rb, F, P, row0 + 120); rowraw0_compute(ra, F, P, row0 + 112);
    rowraw0_compute(rb, F, P, row0 + 120);
}
__device__ __forceinline__ void row_pass(const Frame& F0, const Args& P, int L, int stage) {
    const Frame F = relaunder(F0);
    LAS float* V = (LAS float*)F.lds;
    const bool want_a = !(stage == 2 && L == DEPTH - 1), do_ctx = !(L == DEPTH - 1 && stage > 0);
    const float* gn = inp(P, I_GNORM);
    for (int part = 0; part < (do_ctx ? 2 : 1); ++part) {
        for (int c = F.bid; c < 256; c += F.G) {
            const int r = part == 0 ? (c >> 5) : 8;
            __syncthreads();
            { const int e = 4 * F.tid;
              if (stage > 0) { const f32x4 gt = *(const f32x4*)(modp(F, P, L, r, 2) + e), gg = *(const f32x4*)(gn + (size_t)(L * 4 + 1) * D + e); *(LAS f32x4*)(V + e) = gt * gg; }
              if (stage == 2) { const f32x4 gt = *(const f32x4*)(modp(F, P, L, r, 5) + e), gg = *(const f32x4*)(gn + (size_t)(L * 4 + 3) * D + e); *(LAS f32x4*)(V + D + e) = gt * gg; }
              if (want_a) { const int La = (stage == 2) ? L + 1 : L, sl = (stage == 1) ? 3 : 0;
                  const f32x4 sh = *(const f32x4*)(modp(F, P, La, r, sl) + e), sc = *(const f32x4*)(modp(F, P, La, r, sl + 1) + e), gg = *(const f32x4*)(gn + (size_t)(La * 4 + (stage == 1 ? 2 : 0)) * D + e);
                  *(LAS f32x4*)(V + 2 * D + e) = gg * (sc + 1.0f); *(LAS f32x4*)(V + 3 * D + e) = sh; } }
            __syncthreads();
            if (stage < 2) {
                if (part == 0) { if (stage == 0) row_lat_pipe0(F, P, c * 128 + F.wave); else row_lat_pipe<1, false>(F, P, c * 128 + F.wave); }
                else row_stage01<1>(F, P, L, stage, ML + c * 8 + F.wave, 0);
            } else {
                if (part == 0) { if (L == DEPTH - 1) row_lat_pipe<2, true>(F, P, c * 128 + F.wave); else row_lat_pipe<2, false>(F, P, c * 128 + F.wave); }
                else row_stage2<1>(F, P, L, want_a, ML + c * 8 + F.wave, 0);
            }
        }
    }
}

__device__ __forceinline__ void gla_gate(const Frame& F0, const Args& P, int L) {
    typedef short bf16x8_t __attribute__((ext_vector_type(8)));
    const Frame F = relaunder(F0);
    const int j = L / 3, lane = F.lane, n16 = lane & 15, q4 = lane >> 4;
    bf16x8_t af[16]; f32x4 bv[16];
    { const v4u* src = (const v4u*)(wsp(P) + WS_WF + (size_t)j * 131072); const float* gb = inp(P, I_GBG) + j * 2048;
#pragma unroll
      for (int t = 0; t < 16; ++t) { const int dt = F.wave * 16 + t; af[t] = __builtin_bit_cast(bf16x8_t, src[dt * 64 + lane]); bv[t] = *(const f32x4*)(gb + 16 * dt + 4 * q4); } }
    const float* U = (const float*)(wsp(P) + WS_GU); bf16* X = (bf16*)(wsp(P) + WS_BIG);
#define GG_LOAD(u0, u1, g) { const float* up = U + (size_t)(16 * (g) + n16) * 32 + 8 * q4; u0 = *(const f32x4*)up; u1 = *(const f32x4*)(up + 4); }
#define GG_BODY(u0, u1, g) { \
        const v4u bw = {pk2(u0[0], u0[1]), pk2(u0[2], u0[3]), pk2(u1[0], u1[1]), pk2(u1[2], u1[3])}; \
        const bf16x8_t bfr = __builtin_bit_cast(bf16x8_t, bw); \
        bf16* xr = X + (size_t)(16 * (g) + n16) * BIG_LD + 6144 + 256 * F.wave + 4 * q4; \
        _Pragma("unroll") for (int t = 0; t < 16; ++t) { \
            f32x4 z = __builtin_amdgcn_mfma_f32_16x16x32_bf16(af[t], bfr, bv[t], 0, 0, 0);     \
            v2u w; w.x = pk2(pg8::logsig16(z[0]), pg8::logsig16(z[1])); w.y = pk2(pg8::logsig16(z[2]), pg8::logsig16(z[3])); \
            *(v2u*)(xr + 16 * t) = w; } }
    constexpr int NG = MT / 16;
    int g = F.bid; f32x4 a0, a1, b0, b1;
    if (g < NG) GG_LOAD(a0, a1, g);
    while (g < NG) {
        const int g2 = g + F.G; if (g2 < NG) GG_LOAD(b0, b1, g2);
        GG_BODY(a0, a1, g);
        if (g2 >= NG) break;
        const int g3 = g2 + F.G; if (g3 < NG) GG_LOAD(a0, a1, g3);
        GG_BODY(b0, b1, g2);
        g = g3;
    }
#undef GG_LOAD
#undef GG_BODY
}

namespace gsc {
typedef short bf16x8 __attribute__((ext_vector_type(8)));
typedef short s16x4 __attribute__((ext_vector_type(4)));
typedef float f32x4 __attribute__((ext_vector_type(4)));
typedef float f32x2 __attribute__((ext_vector_type(2)));
typedef __bf16 bf16x2_t __attribute__((ext_vector_type(2)));
__device__ __forceinline__ unsigned cvt2(float lo, float hi) { f32x2 v = {lo, hi}; bf16x2_t b = __builtin_convertvector(v, bf16x2_t); return __builtin_bit_cast(unsigned, b); }
__device__ __forceinline__ unsigned off_b(unsigned row, unsigned ch) { return 256u * row + 16u * (ch ^ (((row & 3) << 2) | ((row >> 2) & 3))); }
__device__ __forceinline__ s16x4 tr_read(unsigned addr) { s16x4 r; asm volatile("ds_read_b64_tr_b16 %0, %1\n\ts_waitcnt lgkmcnt(0)" : "=&v"(r) : "v"(addr) : "memory"); return r; }
constexpr int QDS = 528, KTS = 144, QDS2 = 544;
constexpr int O_QD = 0, O_KD = 33792, O_KDT = 67584, O_V = 104448, O_ATT = 120832, O_TOT = 130048, O_EDEC = 134144;
}
constexpr size_t PREP_ITEM = 74752, PREP_KDT = 32768, PREP_ATT = 65536, PREP_EDEC = 73728;
constexpr size_t WS_PREP = WS_PART;
static_assert(WS_PREP + (size_t)NB * 4 * 2 * 68 * PREP_ITEM <= (size_t)1610612736, "prep tiles must fit below the guaranteed workspace size");
__device__ __forceinline__ void gla_prep(const Frame& F0, const Args& P) {
    using namespace gsc;
    const Frame F = relaunder(F0);
    const bf16* X = (const bf16*)(wsp(P) + WS_BIG);
    const int t = F.tid, w = F.wave, lane = F.lane, n16 = lane & 15, q4 = lane >> 4;
    LAS unsigned char* L = F.lds;
    const int dp = t & 127, rq = t >> 7, d0 = 2 * dp;
    constexpr int NIT = NB * 4 * 68 * 2;
    unsigned rQ[16], rK[16], rG[16];
#define GPR_LOAD(it_) do { const int dir_ = (it_) & 1, ci_ = ((it_) >> 1) % 68, hh_ = (((it_) >> 1) / 68) & 3, b_ = ((it_) >> 1) / 272; \
        const int r0_ = ci_ < 4 ? ML + b_ * CTXL + ci_ * 64 : b_ * SEQ + (ci_ - 4) * 64; const bf16* xp_ = X + (size_t)(r0_ + 16 * rq) * BIG_LD + hh_ * 256 + d0; \
        _Pragma("unroll") for (int r = 0; r < 16; ++r) { rQ[r] = *(const unsigned*)(xp_ + (size_t)r * BIG_LD); rK[r] = *(const unsigned*)(xp_ + (size_t)r * BIG_LD + 1024); rG[r] = *(const unsigned*)(xp_ + (size_t)r * BIG_LD + 6144 + dir_ * 1024); } } while (0)
    if (F.vb < NIT) GPR_LOAD(F.vb);
    for (int it = F.vb; it < NIT; it += F.G) {
        const int dir = it & 1, cidx = (it >> 1) % 68, hh = ((it >> 1) / 68) & 3, b = (it >> 1) / 272;
        float bb0[16], bb1[16]; float run0 = 0.f, run1 = 0.f;
        if (dir == 0) {
#pragma unroll
            for (int r = 0; r < 16; ++r) { run0 += bflo(rG[r]); run1 += bfhi(rG[r]); bb0[r] = run0; bb1[r] = run1; }
        } else {
#pragma unroll
            for (int r = 15; r >= 0; --r) { run0 += bflo(rG[r]); run1 += bfhi(rG[r]); bb0[r] = run0; bb1[r] = run1; }
        }
        *(LAS f32x2*)(L + O_TOT + (rq * 256 + d0) * 4) = (f32x2){run0, run1};
        __syncthreads();
        float off0 = 0.f, off1 = 0.f, bt0 = 0.f, bt1 = 0.f;
#pragma unroll
        for (int g = 0; g < 4; ++g) { const f32x2 tv = *(const LAS f32x2*)(L + O_TOT + (g * 256 + d0) * 4); bt0 += tv[0]; bt1 += tv[1];
            const bool inc = (dir == 0) ? (g < rq) : (g > rq); off0 += inc ? tv[0] : 0.f; off1 += inc ? tv[1] : 0.f; }
        const float ed0 = __expf(bt0), ed1 = __expf(bt1);
        if (rq == 0) *(LAS f32x2*)(L + O_EDEC + d0 * 4) = (f32x2){ed0, ed1};
        unsigned kt0[8], kt1[8];
#pragma unroll
        for (int r = 0; r < 16; r += 2) {
            float kd0[2], kd1[2];
#pragma unroll
            for (int u = 0; u < 2; ++u) { const float b0 = bb0[r + u] + off0, b1 = bb1[r + u] + off1;
                const float q0 = bflo(rQ[r + u]), q1 = bfhi(rQ[r + u]), k0 = bflo(rK[r + u]), k1 = bfhi(rK[r + u]);
                const float e0 = __expf(fmaxf(b0, -80.f)), e1 = __expf(fmaxf(b1, -80.f)), i0 = __builtin_amdgcn_rcpf(e0), i1 = __builtin_amdgcn_rcpf(e1);
                const float kk0 = k0 * i0, kk1 = k1 * i1;
                *(LAS unsigned*)(L + O_QD + (16 * rq + r + u) * QDS + d0 * 2) = cvt2(q0 * e0, q1 * e1);
                *(LAS unsigned*)(L + O_KD + (16 * rq + r + u) * QDS + d0 * 2) = cvt2(kk0, kk1);
                kd0[u] = kk0 * ed0; kd1[u] = kk1 * ed1; }
            kt0[r >> 1] = cvt2(kd0[0], kd0[1]); kt1[r >> 1] = cvt2(kd1[0], kd1[1]);
        }
        *(LAS v4u*)(L + O_KDT + d0 * KTS + rq * 32) = (v4u){kt0[0], kt0[1], kt0[2], kt0[3]}; *(LAS v4u*)(L + O_KDT + d0 * KTS + rq * 32 + 16) = (v4u){kt0[4], kt0[5], kt0[6], kt0[7]};
        *(LAS v4u*)(L + O_KDT + (d0 + 1) * KTS + rq * 32) = (v4u){kt1[0], kt1[1], kt1[2], kt1[3]}; *(LAS v4u*)(L + O_KDT + (d0 + 1) * KTS + rq * 32 + 16) = (v4u){kt1[4], kt1[5], kt1[6], kt1[7]};
        if (it + F.G < NIT) GPR_LOAD(it + F.G);
        __syncthreads();
        { const int ib = w >> 1, jb0 = (w & 1) * 2; f32x4 a0 = (f32x4){0.f, 0.f, 0.f, 0.f}, a1 = a0;
#pragma unroll
          for (int ks = 0; ks < 8; ++ks) { const int co = (32 * ks + 8 * q4) * 2;
              const bf16x8 af = *(const LAS bf16x8*)(L + O_QD + (16 * ib + n16) * QDS + co);
              const bf16x8 b0 = *(const LAS bf16x8*)(L + O_KD + (16 * jb0 + n16) * QDS + co), b1 = *(const LAS bf16x8*)(L + O_KD + (16 * jb0 + 16 + n16) * QDS + co);
              a0 = __builtin_amdgcn_mfma_f32_16x16x32_bf16(af, b0, a0, 0, 0, 0); a1 = __builtin_amdgcn_mfma_f32_16x16x32_bf16(af, b1, a1, 0, 0, 0); }
#pragma unroll
          for (int r = 0; r < 4; ++r) { const int i = 16 * ib + 4 * q4 + r, j0 = 16 * jb0 + n16, j1 = j0 + 16;
              const bool k0 = (dir == 0) ? (j0 <= i) : (j0 >= i), k1 = (dir == 0) ? (j1 <= i) : (j1 >= i);
              *(LAS bf16*)(L + O_ATT + i * KTS + j0 * 2) = (bf16)f2bf(k0 ? a0[r] : 0.f); *(LAS bf16*)(L + O_ATT + i * KTS + j1 * 2) = (bf16)f2bf(k1 ? a1[r] : 0.f); }
        }
        __syncthreads();
        unsigned char* G = (unsigned char*)wsp(P) + WS_PREP + ((size_t)((b * 4 + hh) * 2 + dir) * 68 + cidx) * PREP_ITEM;
#pragma unroll
        for (int i = 0; i < 4; ++i) { const int idx = t + 512 * i, row = idx >> 5, ch = idx & 31;
            const LAS unsigned char* sp = L + O_QD + row * QDS + (32 * (ch >> 2) + 4 * (ch & 3)) * 2;
            const v2u lo = *(const LAS v2u*)sp, hi = *(const LAS v2u*)(sp + 32); *(v4u*)(G + row * 512 + ch * 16) = (v4u){lo.x, lo.y, hi.x, hi.y}; }
#pragma unroll
        for (int i = 0; i < 4; ++i) { const int idx = t + 512 * i, row = idx >> 3, ch = idx & 7; *(v4u*)(G + PREP_KDT + row * 128 + ch * 16) = *(const LAS v4u*)(L + O_KDT + row * KTS + ch * 16); }
        { const int row = t >> 3, ch = t & 7; *(v4u*)(G + PREP_ATT + row * 128 + ch * 16) = *(const LAS v4u*)(L + O_ATT + row * KTS + ch * 16); }
        if (t < 64) *(v4u*)(G + PREP_EDEC + t * 16) = *(const LAS v4u*)(L + O_EDEC + t * 16);
    }
#undef GPR_LOAD
}
__device__ __forceinline__ void gla_scan2(const Frame& F0, const Args& P) {
    using namespace gsc;
    const Frame F = relaunder(F0);
    const bf16* X = (const bf16*)(wsp(P) + WS_BIG);
    const int t = F.tid, w = F.wave, lane = F.lane, n16 = lane & 15, q4 = lane >> 4;
    LAS unsigned char* L = F.lds;
    const int vr = t >> 3, vc = (t & 7) * 2;
    for (int it = F.vb; it < 256; it += F.G) {
        const int sl = it & 3, dir = (it >> 2) & 1, hh = (it >> 3) & 3, b = it >> 5;
        bf16* O = (bf16*)(wsp(P) + (dir == 0 ? WS_R1 : WS_R2));
        const unsigned char* GB = (const unsigned char*)wsp(P) + WS_PREP + (size_t)((b * 4 + hh) * 2 + dir) * 68 * PREP_ITEM;
        f32x4 S[16];
#pragma unroll
        for (int i = 0; i < 16; ++i) S[i] = (f32x4){0.f, 0.f, 0.f, 0.f};
        v4u rq_[4], rk_[4], ra_, re_, rV0, rV1;
#define GS2_ROW0(s_) ((s_) < 4 ? ML + b * CTXL + (dir == 0 ? (s_) : 3 - (s_)) * 64 : b * SEQ + (dir == 0 ? (s_) - 4 : 67 - (s_)) * 64)
#define GS2_CIDX(s_) (dir == 0 ? (s_) : ((s_) < 4 ? 3 - (s_) : 71 - (s_)))
#define GS2_LOAD(s_) do { const unsigned char* g_ = GB + (size_t)GS2_CIDX(s_) * PREP_ITEM; \
        _Pragma("unroll") for (int i = 0; i < 4; ++i) { const int idx = t + 512 * i; rq_[i] = *(const v4u*)(g_ + (idx >> 5) * 512 + (idx & 31) * 16); rk_[i] = *(const v4u*)(g_ + PREP_KDT + (idx >> 3) * 128 + (idx & 7) * 16); } \
        ra_ = *(const v4u*)(g_ + PREP_ATT + (t >> 3) * 128 + (t & 7) * 16); re_ = *(const v4u*)(g_ + PREP_EDEC + (t & 63) * 16); \
        const v4u* vp_ = (const v4u*)(X + (size_t)(GS2_ROW0(s_) + vr) * BIG_LD + 2048 + hh * 512 + sl * 128 + vc * 8); rV0 = vp_[0]; rV1 = vp_[1]; } while (0)
        GS2_LOAD(0);
        for (int s = 0; s < 68; ++s) {
            const int row0 = GS2_ROW0(s);
            __syncthreads();
#pragma unroll
            for (int i = 0; i < 4; ++i) { const int idx = t + 512 * i; *(LAS v4u*)(L + O_QD + (idx >> 5) * QDS2 + (idx & 31) * 16) = rq_[i]; *(LAS v4u*)(L + O_KDT + (idx >> 3) * KTS + (idx & 7) * 16) = rk_[i]; }
            *(LAS v4u*)(L + O_ATT + (t >> 3) * KTS + (t & 7) * 16) = ra_;
            if (t < 64) *(LAS v4u*)(L + O_EDEC + t * 16) = re_;
            *(LAS v4u*)(L + O_V + off_b(vr, vc)) = rV0; *(LAS v4u*)(L + O_V + off_b(vr, vc + 1)) = rV1;
            if (s + 1 < 68) GS2_LOAD(s + 1);
            __syncthreads();
#define GS2_SB() __builtin_amdgcn_sched_barrier(0)
            bf16x8 vf[2];
            { const unsigned qq = (lane & 15) >> 2, pp = lane & 3, vb_ = (unsigned)(uintptr_t)(L + O_V) + 8 * (pp & 1);
              s16x4 t0, t1, t2, t3;
              asm volatile("ds_read_b64_tr_b16 %0, %4\n\tds_read_b64_tr_b16 %1, %5\n\tds_read_b64_tr_b16 %2, %6\n\tds_read_b64_tr_b16 %3, %7\n\ts_waitcnt lgkmcnt(0)"
                           : "=&v"(t0), "=&v"(t1), "=&v"(t2), "=&v"(t3)
                           : "v"(vb_ + off_b(8 * q4 + qq, 2 * w + (pp >> 1))), "v"(vb_ + off_b(8 * q4 + 4 + qq, 2 * w + (pp >> 1))),
                             "v"(vb_ + off_b(32 + 8 * q4 + qq, 2 * w + (pp >> 1))), "v"(vb_ + off_b(32 + 8 * q4 + 4 + qq, 2 * w + (pp >> 1))) : "memory");
              vf[0] = (bf16x8){t0[0], t0[1], t0[2], t0[3], t1[0], t1[1], t1[2], t1[3]}; vf[1] = (bf16x8){t2[0], t2[1], t2[2], t2[3], t3[0], t3[1], t3[2], t3[3]}; }
            f32x4 oa[4];
#pragma unroll
            for (int ib = 0; ib < 4; ++ib) oa[ib] = (f32x4){0.f, 0.f, 0.f, 0.f};
            bf16x8 aq[2][4];
#define GS2_LDQ(set, kb) do { _Pragma("unroll") for (int ib = 0; ib < 4; ++ib) aq[set][ib] = *(const LAS bf16x8*)(L + O_QD + (16 * ib + n16) * QDS2 + (32 * (kb) + 8 * q4) * 2); } while (0)
            bf16x8 at[2][4];
#define GS2_LDA(ks) do { _Pragma("unroll") for (int ib = 0; ib < 4; ++ib) at[ks][ib] = *(const LAS bf16x8*)(L + O_ATT + (16 * ib + n16) * KTS + (32 * (ks) + 8 * q4) * 2); } while (0)
            GS2_LDQ(0, 0); GS2_SB();
#pragma unroll
            for (int kb = 0; kb < 8; ++kb) {
                if (kb < 7) GS2_LDQ((kb + 1) & 1, kb + 1); else GS2_LDA(0);
                GS2_SB();
                const v4u sw = {cvt2(S[2 * kb][0], S[2 * kb][1]), cvt2(S[2 * kb][2], S[2 * kb][3]), cvt2(S[2 * kb + 1][0], S[2 * kb + 1][1]), cvt2(S[2 * kb + 1][2], S[2 * kb + 1][3])};
                const bf16x8 sb = __builtin_bit_cast(bf16x8, sw);
#pragma unroll
                for (int ib = 0; ib < 4; ++ib) oa[ib] = __builtin_amdgcn_mfma_f32_16x16x32_bf16(sb, aq[kb & 1][ib], oa[ib], 0, 0, 0);
                GS2_SB();
            }
            f32x4 ed[2]; bf16x8 kf[2][2];
#define GS2_LDD(set, db) do { ed[set] = *(const LAS f32x4*)(L + O_EDEC + (16 * (db) + 4 * q4) * 4); \
                kf[set][0] = *(const LAS bf16x8*)(L + O_KDT + (16 * (db) + n16) * KTS + (8 * q4) * 2); kf[set][1] = *(const LAS bf16x8*)(L + O_KDT + (16 * (db) + n16) * KTS + (32 + 8 * q4) * 2); } while (0)
            GS2_LDA(1); GS2_SB();
#pragma unroll
            for (int ib = 0; ib < 4; ++ib) oa[ib] = __builtin_amdgcn_mfma_f32_16x16x32_bf16(vf[0], at[0][ib], oa[ib], 0, 0, 0);
            GS2_SB(); GS2_LDD(0, 0); GS2_SB();
#pragma unroll
            for (int ib = 0; ib < 4; ++ib) oa[ib] = __builtin_amdgcn_mfma_f32_16x16x32_bf16(vf[1], at[1][ib], oa[ib], 0, 0, 0);
            GS2_SB();
#pragma unroll
            for (int ib = 0; ib < 4; ++ib) *(v2u*)(O + (size_t)(row0 + 16 * ib + n16) * D + hh * 512 + sl * 128 + 16 * w + 4 * q4) = (v2u){cvt2(oa[ib][0], oa[ib][1]), cvt2(oa[ib][2], oa[ib][3])};
#pragma unroll
            for (int db = 0; db < 16; ++db) {
                if (db < 15) GS2_LDD((db + 1) & 1, db + 1);
                GS2_SB();
                f32x4 acc = S[db] * ed[db & 1];
                acc = __builtin_amdgcn_mfma_f32_16x16x32_bf16(kf[db & 1][0], vf[0], acc, 0, 0, 0);
                acc = __builtin_amdgcn_mfma_f32_16x16x32_bf16(kf[db & 1][1], vf[1], acc, 0, 0, 0);
                S[db] = acc;
                GS2_SB();
            }
        }
#undef GS2_SB
#undef GS2_LDQ
#undef GS2_LDA
#undef GS2_LDD
#undef GS2_ROW0
#undef GS2_CIDX
#undef GS2_LOAD
    }
}

__device__ __forceinline__ void gla_post(const Frame& F0, const Args& P, int L) {
    const Frame F = relaunder(F0);
    const int gw = F.bid * NWAVES + F.wave, NGW = F.G * NWAVES; const int nrows = (L == DEPTH - 1) ? ML : MT; const int j = L / 3;
    const bf16* OF = (const bf16*)(wsp(P) + WS_R1); const bf16* OB = (const bf16*)(wsp(P) + WS_R2); bf16* X = (bf16*)(wsp(P) + WS_BIG);
    const float* gh = inp(P, I_GGH) + j * 512 + 8 * F.lane;
    float g[8];
#pragma unroll
    for (int i = 0; i < 8; ++i) g[i] = gh[i];
#define GP_LOAD(R, row) { _Pragma("unroll") for (int hh = 0; hh < 4; ++hh) { R[hh][0] = *(const v4u*)(OF + (size_t)(row) * D + hh * 512 + 8 * F.lane); R[hh][1] = *(const v4u*)(OB + (size_t)(row) * D + hh * 512 + 8 * F.lane); \
            R[hh][2] = *(const v4u*)(X + (size_t)(row) * BIG_LD + 4096 + hh * 512 + 8 * F.lane); } }
#define GP_BODY(R, row) { _Pragma("unroll") for (int hh = 0; hh < 4; ++hh) { const v4u a = R[hh][0], c = R[hh][1], rr = R[hh][2]; \
            float o[8] = {bflo(a.x) + bflo(c.x), bfhi(a.x) + bfhi(c.x), bflo(a.y) + bflo(c.y), bfhi(a.y) + bfhi(c.y), bflo(a.z) + bflo(c.z), bfhi(a.z) + bfhi(c.z), bflo(a.w) + bflo(c.w), bfhi(a.w) + bfhi(c.w)}; \
            const float rv[8] = {bflo(rr.x), bfhi(rr.x), bflo(rr.y), bfhi(rr.y), bflo(rr.z), bfhi(rr.z), bflo(rr.w), bfhi(rr.w)}; \
            float ss = 0.f; \
            _Pragma("unroll") for (int i = 0; i < 8; ++i) ss += o[i] * o[i]; \
            const float rstd = __builtin_amdgcn_rsqf(wave_sum(ss) * (1.0f / 512.0f) + EPS); \
            _Pragma("unroll") for (int i = 0; i < 8; ++i) o[i] = o[i] * rstd * g[i] * (rv[i] * __builtin_amdgcn_rcpf(1.0f + __expf(-rv[i]))); \
            v4u w; w.x = pk2(o[0], o[1]); w.y = pk2(o[2], o[3]); w.z = pk2(o[4], o[5]); w.w = pk2(o[6], o[7]); \
            *(v4u*)(X + (size_t)(row) * BIG_LD + hh * 512 + 8 * F.lane) = w; } }
    v4u ra[4][3], rb[4][3];
    int row = gw;
    if (row < nrows) GP_LOAD(ra, row);
    while (row < nrows) {
        const int r2 = row + NGW; if (r2 < nrows) GP_LOAD(rb, r2);
        GP_BODY(ra, row);
        if (r2 >= nrows) break;
        const int r3 = r2 + NGW; if (r3 < nrows) GP_LOAD(ra, r3);
        GP_BODY(rb, r2);
        row = r3;
    }
#undef GP_LOAD
#undef GP_BODY
}

struct MlaRow { v4u a0, a1; unsigned short x1, x2; float cs, sn; };
__device__ __forceinline__ void mla_norm(const Frame& F0, const Args& P) {
    const Frame F = relaunder(F0);
    const int gw = F.bid * NWAVES + F.wave, NGW = F.G * NWAVES;
    bf16* CB = (bf16*)(wsp(P) + WS_BIG); const float* rt = (const float*)(wsp(P) + WS_ROPE);
    const int f = F.lane & 31;
#define MN_LOAD(R, row) { const bf16* cr = CB + (size_t)(row) * MLA_CN; R.a0 = *(const v4u*)(cr + 8 * F.lane); R.a1 = *(const v4u*)(cr + 512 + 8 * F.lane); \
        if ((row) < ML) { const int tpos = (row) & (SEQ - 1); R.x1 = cr[1024 + f]; R.x2 = cr[1056 + f]; R.cs = rt[tpos * 32 + f]; R.sn = rt[SEQ * 32 + tpos * 32 + f]; } }
#define MN_PART(av, off) { const v4u a = av; float v[8] = {bflo(a.x), bfhi(a.x), bflo(a.y), bfhi(a.y), bflo(a.z), bfhi(a.z), bflo(a.w), bfhi(a.w)}; float ss = 0.f; \
        _Pragma("unroll") for (int i = 0; i < 8; ++i) ss += v[i] * v[i]; \
        const float rstd = __builtin_amdgcn_rsqf(wave_sum(ss) * (1.0f / 512.0f) + EPS); \
        v4u w; w.x = pk2(v[0] * rstd, v[1] * rstd); w.y = pk2(v[2] * rstd, v[3] * rstd); w.z = pk2(v[4] * rstd, v[5] * rstd); w.w = pk2(v[6] * rstd, v[7] * rstd); \
        *(v4u*)(cr + (off) + 8 * F.lane) = w; }
#define MN_BODY(R, row) { bf16* cr = CB + (size_t)(row) * MLA_CN; MN_PART(R.a0, 0) MN_PART(R.a1, 512) \
        if ((row) < ML) {                                       \
            const float x1 = bf2f(R.x1), x2 = bf2f(R.x2); const float o1 = x1 * R.cs - x2 * R.sn, o2 = x2 * R.cs + x1 * R.sn; \
            if (F.lane < 32) { cr[1024 + f] = (bf16)f2bf(o1); cr[1056 + f] = (bf16)f2bf(o2); } } }
    MlaRow ra, rb;
    int row = gw;
    if (row < MT) MN_LOAD(ra, row);
    while (row < MT) {
        const int r2 = row + NGW; if (r2 < MT) MN_LOAD(rb, r2);
        MN_BODY(ra, row);
        if (r2 >= MT) break;
        const int r3 = r2 + NGW; if (r3 < MT) MN_LOAD(ra, r3);
        MN_BODY(rb, r2);
        row = r3;
    }
#undef MN_LOAD
#undef MN_PART
#undef MN_BODY
}

__device__ __forceinline__ void swa_krope(const Frame& F0, const Args& P) {
    const Frame F = relaunder(F0);
    const int gw = F.bid * NWAVES + F.wave, NGW = F.G * NWAVES;
    bf16* X = (bf16*)(wsp(P) + WS_BIG); const float* rt = (const float*)(wsp(P) + WS_ROPE);
    for (int row = gw; row < ML; row += NGW) {
        const int tpos = row & (SEQ - 1); bf16* kr = X + (size_t)row * SWA_N + 2048;
#pragma unroll
        for (int i = 0; i < 2; ++i) { const int p = F.lane + 64 * i, hh = p >> 5, f = p & 31;
            const float x1 = bf2f(kr[hh * 64 + f]), x2 = bf2f(kr[hh * 64 + 32 + f]); const float cs = rt[tpos * 32 + f], sn = rt[SEQ * 32 + tpos * 32 + f];
            kr[hh * 64 + f] = (bf16)f2bf(x1 * cs - x2 * sn); kr[hh * 64 + 32 + f] = (bf16)f2bf(x2 * cs + x1 * sn); }
    }
}

namespace att {
typedef short bf16x8 __attribute__((ext_vector_type(8)));
typedef short s16x4 __attribute__((ext_vector_type(4)));
typedef float f32x16 __attribute__((ext_vector_type(16)));
typedef unsigned u32x4 __attribute__((ext_vector_type(4)));
#define ATT_SBAR() __builtin_amdgcn_sched_barrier(0)
__device__ __forceinline__ int crow(int r, int hi) { return (r & 3) + 8 * (r >> 2) + 4 * hi; }
__device__ __forceinline__ unsigned cvtpk(float lo, float hi) { unsigned r; asm volatile("v_cvt_pk_bf16_f32 %0, %1, %2" : "=v"(r) : "v"(lo), "v"(hi)); return r; }
template <int OFF> __device__ __forceinline__ s16x4 tr_read(int vb) { s16x4 r; asm volatile("ds_read_b64_tr_b16 %0, %1 offset:%2" : "=&v"(r) : "v"(vb), "i"(OFF) : "memory"); return r; }
__device__ __forceinline__ int v_rd_base(int lane) { return ((lane & 3) << 3) | (((lane >> 2) & 3) << 6) | (((lane >> 4) & 1) << 5) | (((lane >> 5) & 1) << 8); }

template <int KIND> struct Cfg;
template <> struct Cfg<0> { static constexpr int DQK = 192, DV = 128, NH = 16; static constexpr float SCALE = 0.07216878364870322f; };
template <> struct Cfg<1> { static constexpr int DQK = 64, DV = 64, NH = 32; static constexpr float SCALE = 0.125f; };

template <int KIND> struct Body {
    static constexpr int DQK = Cfg<KIND>::DQK, DV = Cfg<KIND>::DV, ND0 = DQK / 16, NCB = DV / 32, KROWB = DQK * 2;
    static constexpr int SHM_K = 64 * KROWB, SHM_V = 64 * DV * 2;
    static constexpr float SCALE = Cfg<KIND>::SCALE, THR = 8.f;
    static __device__ __forceinline__ int kswz(int row, int colB) { return row * KROWB + (colB ^ ((row & 7) << 4)); }
    static __device__ __forceinline__ int v_st(int k, int c) { const int kk = (k & ~0xC) | ((k & 4) << 1) | ((k & 8) >> 1); return ((kk >> 3) * NCB + (c >> 5)) * 512 + ((kk & 7) * 32 + (c & 31)) * 2; }
    static constexpr int v_rd_off(int d0, int ks, int half) { return d0 * 512 + ks * NCB * 1024 + half * NCB * 512; }

    static __device__ __forceinline__ void partialSM(f32x16& p0, f32x16& p1, float& m_reg, float& mn, float& alpha) {
        constexpr float C = SCALE * 1.4426950408889634f;
        float pmax = p0[0];
#pragma unroll
        for (int r = 1; r < 16; ++r) pmax = fmaxf(pmax, p0[r]);
#pragma unroll
        for (int r = 0; r < 16; ++r) pmax = fmaxf(pmax, p1[r]);
        { auto rr = __builtin_amdgcn_permlane32_swap(__float_as_uint(pmax), __float_as_uint(pmax), false, false); pmax = fmaxf(__uint_as_float(rr[0]), __uint_as_float(rr[1])); }
        if (__builtin_expect(__all(pmax - m_reg <= THR / SCALE), 1)) { mn = m_reg; alpha = 1.f; }
        else { mn = fmaxf(m_reg, pmax); alpha = __builtin_amdgcn_exp2f((m_reg - mn) * C); m_reg = mn; }
        const float mnC = -mn * C;
#pragma unroll
        for (int r = 0; r < 16; ++r) p0[r] = fmaf(p0[r], C, mnC);
#pragma unroll
        for (int r = 0; r < 16; ++r) p1[r] = fmaf(p1[r], C, mnC);
#pragma unroll
        for (int r = 0; r < 16; ++r) p0[r] = __builtin_amdgcn_exp2f(p0[r]);
    }
    static __device__ __forceinline__ void finishSM(f32x16& p0, f32x16& p1, float alpha, float& l_reg, bf16x8& pa0, bf16x8& pa1, bf16x8& pa2, bf16x8& pa3) {
#pragma unroll
        for (int r = 0; r < 16; ++r) p1[r] = __builtin_amdgcn_exp2f(p1[r]);
        float ps = 0;
#pragma unroll
        for (int r = 0; r < 16; ++r) ps += p0[r];
#pragma unroll
        for (int r = 0; r < 16; ++r) ps += p1[r];
        { auto rr = __builtin_amdgcn_permlane32_swap(__float_as_uint(ps), __float_as_uint(ps), false, false); ps = __uint_as_float(rr[0]) + __uint_as_float(rr[1]); }
        l_reg = l_reg * alpha + ps;
#define ATT_PK4(P, BASE, OUT) do { unsigned a0 = cvtpk(P[BASE + 0], P[BASE + 1]), a1 = cvtpk(P[BASE + 2], P[BASE + 3]);   \
    unsigned b0 = cvtpk(P[BASE + 4], P[BASE + 5]), b1 = cvtpk(P[BASE + 6], P[BASE + 7]);                              \
    auto r0 = __builtin_amdgcn_permlane32_swap(a0, b0, false, false); auto r1 = __builtin_amdgcn_permlane32_swap(a1, b1, false, false); \
    u32x4 w = {r0[0], r1[0], r0[1], r1[1]}; OUT = __builtin_bit_cast(bf16x8, w); } while (0)
        ATT_PK4(p0, 0, pa0); ATT_PK4(p0, 8, pa1); ATT_PK4(p1, 0, pa2); ATT_PK4(p1, 8, pa3);
#undef ATT_PK4
    }
    static __device__ __forceinline__ void kbases(int (&kb)[4], int r32, int hi) {
#pragma unroll
        for (int i = 0; i < 4; ++i) { kb[i] = kswz(r32, i * 32 + hi * 16); asm volatile("" : "+v"(kb[i])); } }
    static __device__ __forceinline__ void qkt(f32x16& p0, f32x16& p1, const LAS char* Ks, const bf16x8 (&qr)[ND0], const int (&kb)[4]) {
        p0 = f32x16{}; p1 = f32x16{};
#pragma unroll
        for (int d0 = 0; d0 < ND0; ++d0) { const LAS char* kp = Ks + kb[d0 & 3] + (d0 >> 2) * 128;
            const bf16x8 b0 = *(const LAS bf16x8*)kp;
            const bf16x8 b1 = *(const LAS bf16x8*)(kp + 32 * KROWB);
            p0 = __builtin_amdgcn_mfma_f32_32x32x16_bf16(b0, qr[d0], p0, 0, 0, 0);
            p1 = __builtin_amdgcn_mfma_f32_32x32x16_bf16(b1, qr[d0], p1, 0, 0, 0); }
    }
    template <int D0> static __device__ __forceinline__ void pv_one(f32x16& od, int vb, bf16x8 pa0, bf16x8 pa1, bf16x8 pa2, bf16x8 pa3) {
        const s16x4 l0 = tr_read<v_rd_off(D0, 0, 0)>(vb), h0 = tr_read<v_rd_off(D0, 0, 1)>(vb), l1 = tr_read<v_rd_off(D0, 1, 0)>(vb), h1 = tr_read<v_rd_off(D0, 1, 1)>(vb);
        const s16x4 l2 = tr_read<v_rd_off(D0, 2, 0)>(vb), h2 = tr_read<v_rd_off(D0, 2, 1)>(vb), l3 = tr_read<v_rd_off(D0, 3, 0)>(vb), h3 = tr_read<v_rd_off(D0, 3, 1)>(vb);
        asm volatile("s_waitcnt lgkmcnt(0)" ::: "memory"); ATT_SBAR();
#define ATT_PK(L, H) (bf16x8){L[0], L[1], L[2], L[3], H[0], H[1], H[2], H[3]}
        od = __builtin_amdgcn_mfma_f32_32x32x16_bf16(pa0, ATT_PK(l0, h0), od, 0, 0, 0);
        od = __builtin_amdgcn_mfma_f32_32x32x16_bf16(pa1, ATT_PK(l1, h1), od, 0, 0, 0);
        od = __builtin_amdgcn_mfma_f32_32x32x16_bf16(pa2, ATT_PK(l2, h2), od, 0, 0, 0);
        od = __builtin_amdgcn_mfma_f32_32x32x16_bf16(pa3, ATT_PK(l3, h3), od, 0, 0, 0);
#undef ATT_PK
    }
    static __device__ __forceinline__ void pv_all(f32x16 (&o)[NCB], int vb, bf16x8 pa0, bf16x8 pa1, bf16x8 pa2, bf16x8 pa3) {
        pv_one<0>(o[0], vb, pa0, pa1, pa2, pa3); pv_one<1>(o[1], vb, pa0, pa1, pa2, pa3);
        if constexpr (NCB == 4) { pv_one<2>(o[2], vb, pa0, pa1, pa2, pa3); pv_one<3>(o[3], vb, pa0, pa1, pa2, pa3); }
    }
};
}

template <int KIND>
__device__ __forceinline__ void attn_mfma(const Frame& F0, const Args& P, bool with_ctx) {
    using B = att::Body<KIND>; using att::bf16x8; using att::f32x16; using att::crow;
    constexpr int DQK = B::DQK, DV = B::DV, ND0 = B::ND0, NCB = B::NCB, NH = att::Cfg<KIND>::NH, SHM_K = B::SHM_K, SHM_V = B::SHM_V;
    const Frame F = relaunder(F0);
    const int tid = F.tid, wid = F.wave, lane = F.lane, r32 = lane & 31, hi = lane >> 5;
#define ATT_OPQ_(x) ({ int v_ = (x); asm volatile("" : "+v"(v_)); v_; })
    constexpr int NST = 3;
    const LAS char* V_lds = (const LAS char*)F.lds; const LAS char* K_lds = (const LAS char*)(F.lds + NST * SHM_V);
    LAS float* wsf = (LAS float*)(F.lds + NST * (SHM_V + SHM_K)) + wid * 64; LAS float* li_l = wsf; LAS float* al_l = wsf + 32;
    static_assert(NST * (SHM_V + SHM_K) + NWAVES * 256 <= LDSCTL_OFF, "attention LDS");
    constexpr int NKB = SHM_K / 8192, NVB = SHM_V / 8192;
    unsigned koff[NKB], voff[NVB];
    { const int l_ = ATT_OPQ_(lane);
#pragma unroll
      for (int i = 0; i < NKB; ++i) { const int p = (wid + 8 * i) * 1024 + 16 * l_; const int row = p / B::KROWB, within = p % B::KROWB, colB = within ^ ((row & 7) << 4);
          if (KIND == 0) koff[i] = colB < 256 ? (unsigned)(row * (MLA_KVN * 2) + colB) : (0x80000000u | (unsigned)(row * (MLA_CN * 2) + (colB - 256)));
          else koff[i] = (unsigned)(row * (SWA_N * 2) + colB); }
#pragma unroll
      for (int i = 0; i < NVB; ++i) { const int p = (wid + 8 * i) * 1024 + 16 * l_; const int blk = p >> 9, r = p & 511; const int kk = (blk / NCB) * 8 + (r >> 6), c = (blk % NCB) * 32 + ((r & 63) >> 1);
          const int k = (kk & ~0xC) | ((kk & 4) << 1) | ((kk & 8) >> 1);
          voff[i] = KIND == 0 ? (unsigned)(k * (MLA_KVN * 2) + (128 + c) * 2) : (unsigned)(k * (SWA_N * 2) + (256 + c) * 2); } }
    const bf16* BIG = (const bf16*)(wsp(P) + WS_BIG); const float* rt = (const float*)(wsp(P) + WS_ROPE);
    const bf16* CB = BIG; const bf16* QB = BIG + (size_t)MT * MLA_CN; const bf16* KVB = QB + (size_t)MT * MLA_QN;
    bf16* O = (bf16*)(wsp(P) + WS_R1);
#define ATT_OPQ(x) ({ int v_ = (x); asm volatile("" : "+v"(v_)); v_; })
#define ATT_VB(bb) ((int)(uintptr_t)V_lds + (bb) * SHM_V + att::v_rd_base(ATT_OPQ(lane)))
    const int n_lat = KIND == 0 ? NB * NH * 16 : NB * 4 * 32 * 4, n_ctx = with_ctx ? (KIND == 0 ? NB * NH : NB * 4 * 8) : 0;
    for (int u = F.vb; u < n_lat + n_ctx; u += F.G) {
        const bool isctx = u >= n_lat; const int uu = isctx ? u - n_lat : u;
        int b, head, kvh, qrow, tq = 0, nblk = 0, NT;
        if (KIND == 0) {
            if (!isctx) { const int qb = uu & 15; head = (uu >> 4) & 15; b = uu >> 8; tq = qb * 256 + wid * 32 + r32; qrow = b * SEQ + tq; NT = 68; }
            else { head = uu & 15; b = uu >> 4; qrow = ML + b * CTXL + wid * 32 + r32; NT = 4; }
            kvh = head;
        } else {
            if (!isctx) { const int sub = uu & 3; nblk = (uu >> 2) & 31; kvh = (uu >> 7) & 3; b = uu >> 9; head = kvh * 8 + sub * 2 + (wid >> 2); tq = nblk * 128 + (wid & 3) * 32 + r32; qrow = b * SEQ + tq;
                NT = 10 - ((nblk == 0 || nblk == 31) ? 2 : 0); }
            else { const int sub = uu & 7; kvh = (uu >> 3) & 3; b = uu >> 5; head = kvh * 8 + sub; qrow = ML + b * CTXL + wid * 32 + r32; NT = 4; }
        }
        const int wt0 = (KIND == 1 && !isctx && nblk == 0) ? 2 : 0;
#define ATT_KROW(kt) ((kt) < 4 ? ML + b * CTXL + (kt) * 64 : (KIND == 0 ? b * SEQ + ((kt) - 4) * 64 : b * SEQ + (nblk - 1) * 128 + ((kt) - 4 + wt0) * 64))
#define ATT_DMA(kt, st) do { const int kr_ = ATT_KROW(kt); \
        if (KIND == 0) { const char* kvb_ = (const char*)(KVB + (size_t)kr_ * MLA_KVN + kvh * 256); const char* cbb_ = (const char*)(CB + (size_t)kr_ * MLA_CN + 1024); \
            _Pragma("unroll") for (int i = 0; i < NKB; ++i) { const unsigned o_ = koff[i]; const char* src_ = (o_ >> 31) ? cbb_ + (o_ & 0x7fffffffu) : kvb_ + o_; \
                __builtin_amdgcn_global_load_lds((const unsigned*)src_, (LAS unsigned*)(F.lds + NST * SHM_V + (st) * SHM_K + (wid + 8 * i) * 1024), 16, 0, 0); } \
            _Pragma("unroll") for (int i = 0; i < NVB; ++i) __builtin_amdgcn_global_load_lds((const unsigned*)(kvb_ + voff[i]), (LAS unsigned*)(F.lds + (st) * SHM_V + (wid + 8 * i) * 1024), 16, 0, 0); } \
        else { const char* kb_ = (const char*)(BIG + (size_t)kr_ * SWA_N + 2048 + kvh * 64); \
            __builtin_amdgcn_global_load_lds((const unsigned*)(kb_ + koff[0]), (LAS unsigned*)(F.lds + NST * SHM_V + (st) * SHM_K + wid * 1024), 16, 0, 0); \
            __builtin_amdgcn_global_load_lds((const unsigned*)(kb_ + voff[0]), (LAS unsigned*)(F.lds + (st) * SHM_V + wid * 1024), 16, 0, 0); } } while (0)
        __syncthreads();
        ATT_DMA(0, 0); ATT_DMA(1, 1);
        bf16x8 qr[ND0];
        { const bf16* Qw = (KIND == 0 ? QB + (size_t)qrow * MLA_QN + head * 192 : BIG + (size_t)qrow * SWA_N + head * 64) + hi * 8;
#pragma unroll
          for (int d0 = 0; d0 < ND0; ++d0) qr[d0] = *(const bf16x8*)(Qw + d0 * 16);
          if (!isctx) { constexpr int RB = KIND == 0 ? 8 : 0;
#pragma unroll
            for (int i = 0; i < 2; ++i) { const float* cp = rt + ATT_OPQ(tq * 32 + hi * 8) + i * 16; const float* sp = cp + SEQ * 32;
                const f32x4 c0 = *(const f32x4*)cp, c1 = *(const f32x4*)(cp + 4), s0 = *(const f32x4*)sp, s1 = *(const f32x4*)(sp + 4);
                const float cs[8] = {c0[0], c0[1], c0[2], c0[3], c1[0], c1[1], c1[2], c1[3]}, sn[8] = {s0[0], s0[1], s0[2], s0[3], s1[0], s1[1], s1[2], s1[3]};
                float y1[8], y2[8];
#pragma unroll
                for (int j = 0; j < 8; ++j) { const float x1 = bf2f((bf16)qr[RB + i][j]), x2 = bf2f((bf16)qr[RB + 2 + i][j]); y1[j] = x1 * cs[j] - x2 * sn[j]; y2[j] = x2 * cs[j] + x1 * sn[j]; }
                att::u32x4 w1 = {att::cvtpk(y1[0], y1[1]), att::cvtpk(y1[2], y1[3]), att::cvtpk(y1[4], y1[5]), att::cvtpk(y1[6], y1[7])};
                att::u32x4 w2 = {att::cvtpk(y2[0], y2[1]), att::cvtpk(y2[2], y2[3]), att::cvtpk(y2[4], y2[5]), att::cvtpk(y2[6], y2[7])};
                qr[RB + i] = __builtin_bit_cast(bf16x8, w1); qr[RB + 2 + i] = __builtin_bit_cast(bf16x8, w2); } }
        }
        int kb[4]; B::kbases(kb, r32, hi);
        float m_reg = -1e30f, l_reg = 0.f;
        if (KIND == 1) { m_reg = inp(P, I_SSINK)[head] * (1.0f / B::SCALE); l_reg = 1.0f; }
        f32x16 o[NCB];
#pragma unroll
        for (int d = 0; d < NCB; ++d) o[d] = f32x16{};
#define ATT_VMW() asm volatile("s_waitcnt vmcnt(0)" ::: "memory")
#define ATT_RESC(a) do { if (__any((a) < 1.f)) { if (hi == 0) al_l[r32] = (a); asm volatile("s_waitcnt lgkmcnt(0)" ::: "memory"); \
        _Pragma("unroll") for (int d = 0; d < NCB; ++d) _Pragma("unroll") for (int r = 0; r < 16; ++r) o[d][r] *= al_l[crow(r, hi)]; } } while (0)
#define ATT_MASK(p0, p1, kt) do { if (KIND == 1 && !isctx && (kt) >= 4) { const int k0_ = (nblk - 1) * 128 + ((kt) - 4 + wt0) * 64, dq = tq - k0_; const int dw_ = __builtin_amdgcn_readfirstlane(tq - r32) - k0_; \
        if (dw_ + 31 > 128 || dw_ - 63 < -128)     \
        _Pragma("unroll") for (int r = 0; r < 16; ++r) { const int d0_ = dq - crow(r, hi), d1_ = d0_ - 32; \
            if (d0_ > 128 || d0_ < -128) p0[r] = -INFINITY; if (d1_ > 128 || d1_ < -128) p1[r] = -INFINITY; } } } while (0)
        f32x16 pA0, pA1, pB0, pB1; float mnA, mnB, alA, alB; bf16x8 pa0, pa1, pa2, pa3;
#define ATT_NX(s_) ((s_) == NST - 1 ? 0 : (s_) + 1)
#define ATT_PV_(s_) ((s_) == 0 ? NST - 1 : (s_) - 1)
        ATT_VMW(); __syncthreads();
        B::qkt(pA0, pA1, K_lds, qr, kb); ATT_MASK(pA0, pA1, 0); B::partialSM(pA0, pA1, m_reg, mnA, alA);
        int sj = 1;
        for (int j = 1; j + 1 < NT; j += 2) {
            { const int sn = ATT_NX(sj); ATT_DMA(j + 1, sn); }
            ATT_SBAR(); B::qkt(pB0, pB1, K_lds + sj * SHM_K, qr, kb); ATT_MASK(pB0, pB1, j);
            B::finishSM(pA0, pA1, alA, l_reg, pa0, pa1, pa2, pa3); ATT_SBAR();
            B::pv_all(o, ATT_VB(ATT_PV_(sj)), pa0, pa1, pa2, pa3); B::partialSM(pB0, pB1, m_reg, mnB, alB);
            ATT_RESC(alB); ATT_VMW(); __syncthreads();
            sj = ATT_NX(sj);
            if (j + 2 < NT) { const int sn = ATT_NX(sj); ATT_DMA(j + 2, sn); }
            ATT_SBAR(); B::qkt(pA0, pA1, K_lds + sj * SHM_K, qr, kb); ATT_MASK(pA0, pA1, j + 1);
            B::finishSM(pB0, pB1, alB, l_reg, pa0, pa1, pa2, pa3); ATT_SBAR();
            B::pv_all(o, ATT_VB(ATT_PV_(sj)), pa0, pa1, pa2, pa3); B::partialSM(pA0, pA1, m_reg, mnA, alA);
            ATT_RESC(alA); ATT_VMW(); __syncthreads();
            sj = ATT_NX(sj);
        }
        ATT_SBAR(); B::qkt(pB0, pB1, K_lds + sj * SHM_K, qr, kb); ATT_MASK(pB0, pB1, NT - 1);
        B::finishSM(pA0, pA1, alA, l_reg, pa0, pa1, pa2, pa3); ATT_SBAR();
        B::pv_all(o, ATT_VB(ATT_PV_(sj)), pa0, pa1, pa2, pa3); B::partialSM(pB0, pB1, m_reg, mnB, alB);
        ATT_RESC(alB);
        B::finishSM(pB0, pB1, alB, l_reg, pa0, pa1, pa2, pa3); ATT_SBAR();
        B::pv_all(o, ATT_VB(sj), pa0, pa1, pa2, pa3);
#undef ATT_NX
#undef ATT_PV_
        if (hi == 0) li_l[r32] = l_reg; asm volatile("s_waitcnt lgkmcnt(0)" ::: "memory");
        const int qrow_w = qrow - r32;
#pragma unroll
        for (int r = 0; r < 16; ++r) { const int orow = crow(r, hi); const float rl = __builtin_amdgcn_rcpf(li_l[orow]);
            bf16* op = O + (size_t)(qrow_w + orow) * D + head * DV + r32;
#pragma unroll
            for (int d0 = 0; d0 < NCB; ++d0) op[d0 * 32] = (bf16)f2bf(o[d0][r] * rl); }
#undef ATT_KROW
#undef ATT_OPQ
#undef ATT_OPQ_
#undef ATT_VB
#undef ATT_DMA
#undef ATT_VMW
#undef ATT_RESC
#undef ATT_MASK
    }
}

constexpr int PH_PRO = 0, PH_PRE0 = 1, PH_L0 = 2, PH_PER_LAYER = 10, N_PHASES = PH_L0 + DEPTH * PH_PER_LAYER;
__host__ __device__ inline bool phase_exists(int p) {
    if (p < PH_L0) return true;
    const int L = (p - PH_L0) / PH_PER_LAYER, slot = (p - PH_L0) % PH_PER_LAYER, kind = L % 3;
    if (slot == 3) return kind != 2;
    if (slot == 4) return kind == 0;
    return true;
}

__global__ void __launch_bounds__(NTHREADS, 2) mk_fwd(Args args) {
    extern __shared__ __attribute__((aligned(16))) unsigned char lds[];
    Frame F;
    F.lds = (LAS unsigned char*)lds;
    F.tid = threadIdx.x; F.lane = F.tid & 63; F.wave = __builtin_amdgcn_readfirstlane(F.tid >> 6); F.G = gridDim.x; F.bid = blockIdx.x;
    const Args& P = args;
    for (int u = F.tid; u < (LDS_BYTES - LDSCTL_OFF) / 4; u += NTHREADS) ((LAS unsigned*)(F.lds + LDSCTL_OFF))[u] = 0u;
    __syncthreads();
    const int lo = args.ph_lo, hi = args.ph_hi;
    XcdBarrier bar; bar.bar = (unsigned*)(wsp(P) + WS_CTL) + CW_BAR; bar.x = 0; bar.st = nullptr;
    if (hi - lo > 1) bar = xcd_barrier_post((unsigned*)(wsp(P) + WS_CTL) + CW_BAR, (volatile LAS unsigned*)(F.lds + LDSCTL_OFF + 32), F.tid == 0);
#define IN(k) (lo <= (k) && (k) < hi)
#define SEAM(k) do { if ((k) + 1 < hi) for (int xr_ = 0; xr_ < ((REP_MASK & 256) ? 5 : 1); ++xr_) { XcdBarrier bb_ = bar; bb_.bar = (unsigned*)(wsp(P) + WS_CTL) + CW_BAR; xcd_barrier(bb_, hw_tid(F.wave) == 0); } } while (0)
    using pg8::EpiPlain; using pg8::EpiSwiGlu; using pg8::bf16_t;
#define R1 ((bf16_t*)(wsp(P) + WS_R1))
#define R2 ((bf16_t*)(wsp(P) + WS_R2))
#define BIG ((bf16_t*)(wsp(P) + WS_BIG))

    if (IN(PH_PRO)) { for (int rep = 0; rep < REPN(1); ++rep) prologue(F, P); SEAM(PH_PRO); }
    if (IN(PH_PRE0)) { row_pass(F, P, 0, 0); SEAM(PH_PRE0); }
    for (int L = 0; L < DEPTH; ++L) {
        const int base = PH_L0 + L * PH_PER_LAYER, kind = L % 3; const bool last = (L == DEPTH - 1);
        const int Mout = last ? ML : MT;
        if (IN(base + 0)) { for (int rep = 0; rep < REPN(2); ++rep) {
            if (kind == 0) { pg8::EpiGlaIn E{BIG, BIG_LD, (float*)(wsp(P) + WS_GU)};
                pg8::gemm_phase<GLA_N, D, D, D, false, true>(F.lds, R1, (const bf16_t*)(wsp(P) + WS_WGI + (L / 3) * SZ_WGI), MT, F.G, F.bid, E, F.wave); }
            else if (kind == 1) { EpiPlain E{BIG, MLA_CN, nullptr, 0, 0}; pg8::gemm_phase<MLA_CN, D, D, D>(F.lds, R1, (const bf16_t*)(wsp(P) + WS_WMI), MT, F.G, F.bid, E, F.wave); }
            else { EpiPlain E{BIG, SWA_N, nullptr, 0, 0}; pg8::gemm_phase<SWA_N, D, D, D, false, true>(F.lds, R1, (const bf16_t*)(wsp(P) + WS_WSI), MT, F.G, F.bid, E, F.wave); } }
            SEAM(base + 0);
        }
        if (IN(base + 1)) {
            if (kind == 0) gla_gate(F, P, L); else if (kind == 1) mla_norm(F, P); else swa_krope(F, P);
            SEAM(base + 1);
        }
        if (IN(base + 2)) {
            if (kind == 0) gla_prep(F, P);
            else if (kind == 1) { for (int rep = 0; rep < REPN(2); ++rep) {
                { EpiPlain E{BIG + (size_t)MT * MLA_CN, MLA_QN, nullptr, 0, 0}; pg8::gemm_phase<MLA_QN, 512, MLA_CN, 512, false, true>(F.lds, BIG, (const bf16_t*)(wsp(P) + WS_WMUQ), MT, F.G, F.bid, E, F.wave); }
                { EpiPlain E{BIG + (size_t)MT * (MLA_CN + MLA_QN), MLA_KVN, nullptr, 0, 0}; pg8::gemm_phase<MLA_KVN, 512, MLA_CN, 512, false, true>(F.lds, BIG + 512, (const bf16_t*)(wsp(P) + WS_WMUKV), MT, F.G, F.bid, E, F.wave); }
            } }
            else { for (int rep = 0; rep < REPN(8); ++rep) attn_mfma<1>(F, P, !last); }
            SEAM(base + 2);
        }
        if (IN(base + 3) && kind != 2) {
            if (kind == 0) { for (int rep = 0; rep < REPN(4); ++rep) gla_scan2(F, P); }
            else { for (int rep = 0; rep < REPN(16); ++rep) attn_mfma<0>(F, P, !last); }
            SEAM(base + 3);
        }
        if (IN(base + 4) && kind == 0) { gla_post(F, P, L); SEAM(base + 4); }
        if (IN(base + 5)) { for (int rep = 0; rep < REPN(2); ++rep) {
            EpiPlain E{R2, D, (float*)(wsp(P) + WS_PART), ML, MC};
            if (kind == 0) pg8::gemm_phase<D, D, BIG_LD, D, true>(F.lds, BIG, (const bf16_t*)(wsp(P) + WS_WGO + (L / 3) * SZ_WDD), ML, F.G, F.bid, E, F.wave, Mout - ML);
            else pg8::gemm_phase<D, D, D, D, true>(F.lds, R1, (const bf16_t*)(wsp(P) + (kind == 1 ? WS_WMO : WS_WSO)), ML, F.G, F.bid, E, F.wave, Mout - ML); }
            SEAM(base + 5);
        }
        if (IN(base + 6)) { row_pass(F, P, L, 1); SEAM(base + 6); }
        if (IN(base + 7)) { for (int rep = 0; rep < REPN(32); ++rep) {
            EpiSwiGlu E{BIG, DFF}; pg8::gemm_phase<2 * DFF, D, D, D, false, true>(F.lds, R1, (const bf16_t*)(wsp(P) + WS_WFFI + L * SZ_WFFI), Mout, F.G, F.bid, E, F.wave); }
            SEAM(base + 7);
        }
        if (IN(base + 8)) { for (int rep = 0; rep < REPN(64); ++rep) {
            EpiPlain E{R1, D, (float*)(wsp(P) + WS_PART), ML, MC}; pg8::gemm_phase<D, DFF, DFF, DFF, true>(F.lds, BIG, (const bf16_t*)(wsp(P) + WS_WFFO + L * SZ_WFFO), ML, F.G, F.bid, E, F.wave, Mout - ML); }
            SEAM(base + 8);
        }
        if (IN(base + 9)) { row_pass(F, P, L, 2); SEAM(base + 9); }
    }
#undef IN
#undef SEAM
#undef R1
#undef R2
#undef BIG
}

extern "C" void kernel_launch(void* const* d_in, const int* in_sizes, int n_in, void* d_out, int out_size, void* d_ws, size_t ws_size, hipStream_t stream) {
    static int grid = 0;
    if (grid == 0) {
        if (n_in != 24 || out_size != ML * D || ws_size < WS_END) { fprintf(stderr, "kernel_launch: unexpected shapes (n_in %d, out %d, ws %zu < %zu)\n", n_in, out_size, ws_size, (size_t)WS_END); grid = -1; return; }
        int dev = 0, cus = 0;
        if (hipGetDevice(&dev) != hipSuccess || hipDeviceGetAttribute(&cus, hipDeviceAttributeMultiprocessorCount, dev) != hipSuccess) { grid = -1; return; }
        if (hipFuncSetAttribute((const void*)mk_fwd, hipFuncAttributeMaxDynamicSharedMemorySize, LDS_BYTES) != hipSuccess) { fprintf(stderr, "kernel_launch: hipFuncSetAttribute failed\n"); grid = -1; return; }
        int per_cu = 0;
        if (hipOccupancyMaxActiveBlocksPerMultiprocessor(&per_cu, (const void*)mk_fwd, NTHREADS, LDS_BYTES) != hipSuccess || per_cu < 1) fprintf(stderr, "kernel_launch: occupancy query says %d\n", per_cu);
        (void)hipGetLastError();
        grid = cus;
    }
    if (grid < 0) return;
    (void)hipMemsetAsync((char*)d_ws + WS_CTL, 0, (size_t)(CW_BAR + XCD_BAR_WORDS) * 4, stream);
    Args a{};
    for (int i = 0; i < 24; ++i) a.in[i] = (const float*)d_in[i];
    a.out = (float*)d_out; a.ws = (unsigned char*)d_ws;
#if MK_ONE_LAUNCH
    a.ph_lo = 0; a.ph_hi = N_PHASES;
    hipLaunchKernelGGL(mk_fwd, dim3(grid), dim3(NTHREADS), LDS_BYTES, stream, a);
#else
    for (int p = 0; p < N_PHASES; ++p) { if (!phase_exists(p)) continue; a.ph_lo = p; a.ph_hi = p + 1;
        hipLaunchKernelGGL(mk_fwd, dim3(grid), dim3(NTHREADS), LDS_BYTES, stream, a); }
#endif
}
```

```cpp
#include <hip/hip_runtime.h>
#include <cstdio>
#include <cstdint>
#include <type_traits>

#ifndef REP_MASK
#define REP_MASK 0
#endif
#define REPN(bit) ((REP_MASK & (bit)) ? 2 : 1)
#ifndef MK_ONE_LAUNCH
#define MK_ONE_LAUNCH 1
#endif

__device__ __forceinline__ int hw_lane() { int l; asm volatile("v_mbcnt_lo_u32_b32 %0, -1, 0\n\tv_mbcnt_hi_u32_b32 %0, -1, %0" : "=v"(l)); return l; }
__device__ __forceinline__ int hw_tid(int wave) { asm volatile("" : "+s"(wave)); return wave * 64 + hw_lane(); }

namespace pg8 {
#define PG8_LAS __attribute__((address_space(3)))
typedef unsigned short bf16_t;
typedef short bf16x8 __attribute__((ext_vector_type(8)));
typedef float f32x4 __attribute__((ext_vector_type(4)));
typedef unsigned u32x4 __attribute__((ext_vector_type(4)));
constexpr int BM = 256, BK = 64, HALF = 128, HTB = HALF * BK * 2, STAGE_BYTES = 8 * HTB, NXCD = 8, WGM = 8;

__host__ __device__ __forceinline__ int lds_byte(int r, int c) { const int st = (r >> 4) * 2 + (c >> 5), rr = r & 15, cc = c & 31, ob = rr * 64 + cc * 2; return st * 1024 + (ob ^ (((ob >> 9) & 1) << 5)); }
__host__ __device__ __forceinline__ void stage_rc(int b, int& R, int& C) { const int st = b / 1024, sb = b % 1024, swz = sb ^ (((sb >> 9) & 1) << 5); R = (st >> 1) * 16 + swz / 64; C = (st & 1) * 32 + (swz % 64) / 2; }
__host__ __device__ __forceinline__ int perm32(int rho) { const int n = rho >> 4, i = rho & 15; return 8 * (i >> 2) + 4 * n + (i & 3); }

struct Unit { int pm, pn, ko, ks, hm; };
struct Gemm { const bf16_t* A; const bf16_t* Bt; int M, N, K, lda, ldb; };

struct StaticOrder {
    int nM, nN, nwg, G, c;
    __host__ __device__ void init(int M, int N, int G_, int c_) { nM = M / BM; nN = N / BM; nwg = nM * nN; G = G_; c = c_; }
    __host__ __device__ void at(int L, Unit& u) const {
        int wgid = L; { const int q = nwg / NXCD, r = nwg % NXCD, xcd = wgid % NXCD, off = wgid / NXCD; wgid = (xcd < r ? xcd * (q + 1) : r * (q + 1) + (xcd - r) * q) + off; }
        const int nig = WGM * nN, gid = wgid / nig, fm = gid * WGM, gsz = (nM - fm) < WGM ? (nM - fm) : WGM;
        u.pm = fm + ((wgid % nig) % gsz); u.pn = (wgid % nig) / gsz; u.ko = 0; u.ks = -1; u.hm = 0;
    }
    __host__ __device__ bool next(int i, Unit& u) const { const long L = (long)i * G + c; if (L >= nwg) return false; at((int)L, u); return true; }
    __device__ __forceinline__ void a_ready(const Unit&) const {}
    __device__ __forceinline__ void done(const Unit&) const {}
};
struct TailOrder {
    StaticOrder S; int nfull, R;
    __host__ __device__ void init(int M, int N, int G_, int c_) { S.init(M, N, G_, c_); nfull = (S.nwg / G_) * G_; R = S.nwg - nfull; if (2 * R > G_) { nfull = S.nwg; R = 0; } }
    __host__ __device__ bool next(int i, Unit& u) const {
        const long L = (long)i * S.G + S.c;
        if (L < nfull) { S.at((int)L, u); return true; }
        const int r = (int)(L - nfull); if (r >= 2 * R) return false;
        S.at(nfull + (r >= R ? r - R : r), u); u.hm = r >= R ? 2 : 1; return true;
    }
    __device__ __forceinline__ void a_ready(const Unit&) const {}
    __device__ __forceinline__ void done(const Unit&) const {}
};

struct SplitOrder {
    StaticOrder S; int nmain, nsplit, nN, pm0, kq;
    __host__ __device__ void init(int Mmain, int Mextra, int N, int K, int G_, int c_) { S.init(Mmain, N, G_, c_); nmain = S.nwg; nN = N / BM; nsplit = (Mextra / BM) * nN * 4; pm0 = Mmain / BM; kq = K / 4; }
    __host__ __device__ bool next(int i, Unit& u) const {
        const long L = (long)i * S.G + S.c;
        if (L < nmain) return S.next(i, u);
        const int r = (int)(L - nmain); if (r >= nsplit) return false;
        const int per = nsplit >> 2, ks = r / per, rest = r % per, nme = per / nN;
        u.pm = pm0 + rest % nme; u.pn = rest / nme; u.ko = ks * kq; u.ks = ks; u.hm = 0; return true;
    }
    __device__ __forceinline__ void a_ready(const Unit&) const {}
    __device__ __forceinline__ void done(const Unit&) const {}
};

__device__ __forceinline__ unsigned cvt_pk_bf16(float lo, float hi) { unsigned r; asm volatile("v_cvt_pk_bf16_f32 %0, %1, %2" : "=v"(r) : "v"(lo), "v"(hi)); return r; }

__device__ __forceinline__ float logsig16(float z) { const float l = __builtin_amdgcn_logf(1.0f + __builtin_amdgcn_exp2f(fabsf(z) * -1.4426950408889634f));
    return fmaf(l, -0.6931471805599453f * 0.0625f, fminf(z, 0.f) * 0.0625f); }
__device__ __forceinline__ float silu_mul(float g, float u) { return g * __builtin_amdgcn_rcpf(1.0f + __expf(-g)) * u; }
typedef float f32x2 __attribute__((ext_vector_type(2)));
__device__ __forceinline__ f32x2 silu_mul2(f32x2 g, f32x2 u) { const f32x2 t = g * (f32x2){-1.4426950408889634f, -1.4426950408889634f};
    f32x2 e = {__builtin_amdgcn_exp2f(t.x), __builtin_amdgcn_exp2f(t.y)}; e = e + (f32x2){1.0f, 1.0f};
    const f32x2 r = {__builtin_amdgcn_rcpf(e.x), __builtin_amdgcn_rcpf(e.y)}; return (g * u) * r; }

struct EpiPlain {
    static constexpr bool PERM = true, AFTER_DRAIN = false;
    bf16_t* O; int ldc; float* part; int prow0, prows;
    __device__ __forceinline__ void partial(const f32x4 (&acc)[2][2][4][2], const Unit& u, int wr, int wc, int fr, int fq) const {
        const int row0 = u.pm * BM + wr * 64 + fr - prow0, col0 = u.pn * BM + wc * 32 + 8 * fq;
        float* base = part + (size_t)u.ks * prows * ldc;
#pragma unroll
        for (int ai = 0; ai < 2; ++ai)
#pragma unroll
            for (int m = 0; m < 4; ++m) { float* rowp = base + (size_t)(row0 + ai * HALF + m * 16) * ldc + col0;
#pragma unroll
                for (int bj = 0; bj < 2; ++bj) { *(f32x4*)(rowp + bj * HALF) = acc[ai][bj][m][0]; *(f32x4*)(rowp + bj * HALF + 4) = acc[ai][bj][m][1]; } }
    }
    __device__ __forceinline__ void operator()(const f32x4 (&acc)[2][2][4][2], const Unit& u, int wr, int wc, int fr, int fq) const {
        const int row0 = u.pm * BM + wr * 64 + fr, col0 = u.pn * BM + wc * 32 + 8 * fq;
#pragma unroll
        for (int ai = 0; ai < 2; ++ai) { if (u.hm == 2 - ai) continue;
#pragma unroll
            for (int m = 0; m < 4; ++m) { bf16_t* rowp = O + (size_t)(row0 + ai * HALF + m * 16) * ldc + col0;
#pragma unroll
                for (int bj = 0; bj < 2; ++bj) { const f32x4 v0 = acc[ai][bj][m][0], v1 = acc[ai][bj][m][1];
                    u32x4 w; w.x = cvt_pk_bf16(v0[0], v0[1]); w.y = cvt_pk_bf16(v0[2], v0[3]); w.z = cvt_pk_bf16(v1[0], v1[1]); w.w = cvt_pk_bf16(v1[2], v1[3]);
                    *(u32x4*)(rowp + bj * HALF) = w; } } }
    }
};
struct EpiGlaIn {
    static constexpr bool PERM = true, AFTER_DRAIN = false;
    bf16_t* O; int ldc; float* U;
    __device__ __forceinline__ void operator()(const f32x4 (&acc)[2][2][4][2], const Unit& u, int wr, int wc, int fr, int fq) const {
        const int row0 = u.pm * BM + wr * 64 + fr, col0 = u.pn * BM + wc * 32 + 8 * fq;
        if (u.pn == 24) {
            if (wc == 0) {
#pragma unroll
                for (int ai = 0; ai < 2; ++ai) { if (u.hm == 2 - ai) continue;
#pragma unroll
                    for (int m = 0; m < 4; ++m) { float* up = U + (size_t)(row0 + ai * HALF + m * 16) * 32 + 8 * fq; *(f32x4*)up = acc[ai][0][m][0]; *(f32x4*)(up + 4) = acc[ai][0][m][1]; } }
            }
            return;
        }
#pragma unroll
        for (int ai = 0; ai < 2; ++ai) { if (u.hm == 2 - ai) continue;
#pragma unroll
            for (int m = 0; m < 4; ++m) { bf16_t* rowp = O + (size_t)(row0 + ai * HALF + m * 16) * ldc + col0;
#pragma unroll
                for (int bj = 0; bj < 2; ++bj) { const f32x4 v0 = acc[ai][bj][m][0], v1 = acc[ai][bj][m][1];
                    u32x4 w; w.x = cvt_pk_bf16(v0[0], v0[1]); w.y = cvt_pk_bf16(v0[2], v0[3]); w.z = cvt_pk_bf16(v1[0], v1[1]); w.w = cvt_pk_bf16(v1[2], v1[3]);
                    *(u32x4*)(rowp + bj * HALF) = w; } } }
    }
};
struct EpiSwiGlu {
    static constexpr bool PERM = true, AFTER_DRAIN = false;
    bf16_t* O; int ldc;
    __device__ __forceinline__ void operator()(const f32x4 (&acc)[2][2][4][2], const Unit& u, int wr, int wc, int fr, int fq) const {
        const int row0 = u.pm * BM + wr * 64 + fr, col0 = u.pn * HALF + wc * 32 + 8 * fq;
#pragma unroll
        for (int ai = 0; ai < 2; ++ai) { if (u.hm == 2 - ai) continue;
#pragma unroll
            for (int m = 0; m < 4; ++m) { bf16_t* rowp = O + (size_t)(row0 + ai * HALF + m * 16) * ldc + col0;
                const f32x4 g0 = acc[ai][0][m][0], g1 = acc[ai][0][m][1], u0 = acc[ai][1][m][0], u1 = acc[ai][1][m][1];
                const f32x2 a = silu_mul2((f32x2){g0[0], g0[1]}, (f32x2){u0[0], u0[1]}), b = silu_mul2((f32x2){g0[2], g0[3]}, (f32x2){u0[2], u0[3]});
                const f32x2 c = silu_mul2((f32x2){g1[0], g1[1]}, (f32x2){u1[0], u1[1]}), d = silu_mul2((f32x2){g1[2], g1[3]}, (f32x2){u1[2], u1[3]});
                u32x4 w; w.x = cvt_pk_bf16(a.x, a.y); w.y = cvt_pk_bf16(b.x, b.y); w.z = cvt_pk_bf16(c.x, c.y); w.w = cvt_pk_bf16(d.x, d.y);
                *(u32x4*)rowp = w; } }
    }
};

template <int N, int K, int LDA, int LDB, bool SPLIT = false, bool TAIL = false, class Epi>
__device__ __forceinline__ void gemm_phase(PG8_LAS unsigned char* lds, const bf16_t* gA, const bf16_t* gBt, int M, int G, int cid, const Epi& E, int wave_s, int Mextra = 0) {
    const int tid_ = hw_tid(wave_s);
    asm volatile("" : "+s"(G), "+s"(cid));
    const int tid = tid_, wid = __builtin_amdgcn_readfirstlane(tid >> 6), lane = tid & 63, wr = wid >> 2, wc = wid & 3, fr = lane & 15, fq = lane >> 4;
    constexpr int nt_full = K / BK, nt_q = K / 4 / BK;
    static_assert(!SPLIT || (K % 512 == 0 && (K / 4) >= 256 && nt_q % 2 == 0), "split-K shape");
    static_assert(N % 256 == 0 && K % 128 == 0 && K >= 256, "gemm shape");
    static_assert(!(SPLIT && TAIL), "one order");
    typename std::conditional<SPLIT, SplitOrder, typename std::conditional<TAIL, TailOrder, StaticOrder>::type>::type S;
    if constexpr (SPLIT) S.init(M, Mextra, N, K, G, cid); else S.init(M, N, G, cid);
    unsigned voffA[2], voffB[2];
#pragma unroll
    for (int i = 0; i < 2; ++i) { int R, C; stage_rc(tid * 16 + i * 8192, R, C); const int Rb = Epi::PERM ? ((R & ~31) + perm32(R & 31)) : R;
        voffA[i] = (unsigned)(R * LDA + C) * 2u; voffB[i] = (unsigned)(Rb * LDB + C) * 2u; }
    constexpr size_t kstep = (size_t)(BK * 2);
    constexpr size_t hstepA = (size_t)HALF * LDA * 2, hstepB = (size_t)HALF * LDB * 2;
    constexpr size_t tstepA = 2 * hstepA, tstepB = 2 * hstepB;
    const unsigned ldsw = (unsigned)wid * 1024u;
    const int aoff = lds_byte(wr * 64 + fr, fq * 8), boff = lds_byte(wc * 32 + fr, fq * 8);
#define PG8_SA(b, h) (((b) * 2 + (h)) * HTB)
#define PG8_SB(b, h) ((4 + (b) * 2 + (h)) * HTB)
#define PG8_STAGE(bufoff, gbase, voff) do { _Pragma("unroll") for (int _i = 0; _i < 2; ++_i) \
        __builtin_amdgcn_global_load_lds((const unsigned*)((const char*)(gbase) + (voff)[_i]), (PG8_LAS unsigned*)(lds + (bufoff) + ldsw + _i * 8192), 16, 0, 0); } while (0)
#define PG8_LDA(dst, b, h) do { _Pragma("unroll") for (int m = 0; m < 4; ++m) _Pragma("unroll") for (int k = 0; k < 2; ++k) dst[m][k] = *(const PG8_LAS bf16x8*)(lds + PG8_SA(b, h) + aoff + m * 2048 + k * 1024); } while (0)
#define PG8_LDB(dst, b, h) do { _Pragma("unroll") for (int n = 0; n < 2; ++n) _Pragma("unroll") for (int k = 0; k < 2; ++k) dst[n][k] = *(const PG8_LAS bf16x8*)(lds + PG8_SB(b, h) + boff + n * 2048 + k * 1024); } while (0)
#define PG8_MMA(ai, bj, At, Bt) do { __builtin_amdgcn_s_setprio(1); _Pragma("unroll") for (int m = 0; m < 4; ++m) _Pragma("unroll") for (int n = 0; n < 2; ++n) _Pragma("unroll") for (int k = 0; k < 2; ++k) \
        acc[ai][bj][m][n] = __builtin_amdgcn_mfma_f32_16x16x32_bf16(Bt[n][k], At[m][k], acc[ai][bj][m][n], 0, 0, 0); __builtin_amdgcn_s_setprio(0); } while (0)
#define PG8_WAIT_V(n) asm volatile("s_waitcnt vmcnt(" #n ")" ::: "memory")
#define PG8_WAIT_L(n) asm volatile("s_waitcnt lgkmcnt(" #n ")" ::: "memory")
#define PG8_BAR __builtin_amdgcn_s_barrier()
#define PG8_SCHED __builtin_amdgcn_sched_barrier(0)
    Unit cur, nxt; int ui = 0;
    if (!S.next(0, cur)) return;
    f32x4 acc[2][2][4][2];
#pragma unroll
    for (int a = 0; a < 2; ++a)
#pragma unroll
        for (int b = 0; b < 2; ++b)
#pragma unroll
            for (int m = 0; m < 4; ++m)
#pragma unroll
                for (int n = 0; n < 2; ++n) acc[a][b][m][n] = (f32x4){0.f, 0.f, 0.f, 0.f};
    bf16x8 At[4][2], B0[2][2], B1[2][2];
    const char* cA = (const char*)gA + (size_t)cur.pm * tstepA + (SPLIT ? cur.ko * 2 : 0); const char* cB = (const char*)gBt + (size_t)cur.pn * tstepB + (SPLIT ? cur.ko * 2 : 0);
    S.a_ready(cur);
    PG8_STAGE(PG8_SB(0, 0), cB, voffB); PG8_STAGE(PG8_SB(0, 1), cB + hstepB, voffB); PG8_STAGE(PG8_SA(0, 0), cA, voffA); PG8_STAGE(PG8_SA(0, 1), cA + hstepA, voffA);
    if (wr == 1) PG8_BAR;
    PG8_WAIT_V(2); PG8_BAR;
    PG8_STAGE(PG8_SB(1, 0), cB + kstep, voffB); PG8_STAGE(PG8_SA(1, 0), cA + kstep, voffA); PG8_STAGE(PG8_SB(1, 1), cB + hstepB + kstep, voffB);
    PG8_WAIT_V(6); PG8_BAR;
    for (;;) {
        const bool has_next = S.next(ui + 1, nxt);
        const char* nA = has_next ? (const char*)gA + (size_t)nxt.pm * tstepA + (SPLIT ? nxt.ko * 2 : 0) : cA; const char* nB = has_next ? (const char*)gBt + (size_t)nxt.pn * tstepB + (SPLIT ? nxt.ko * 2 : 0) : cB;
        const int nt = (SPLIT && cur.ks >= 0) ? nt_q : nt_full;
#define PG8_KLOOP(HM) \
        for (int t = 0; t < nt; t += 2) { \
            const bool last = (t == nt - 2); \
            const char* a1 = cA + (size_t)(t + 1) * kstep; \
            const char* a2 = last ? nA : cA + (size_t)(t + 2) * kstep; const char* b2 = last ? nB : cB + (size_t)(t + 2) * kstep; \
            const char* a3 = a2 + kstep; const char* b3 = b2 + kstep; \
            if (last && has_next) S.a_ready(nxt); \
            PG8_LDB(B0, 0, 0); PG8_LDB(B1, 0, 1); PG8_SCHED; if (HM != 2) PG8_LDA(At, 0, 0); PG8_STAGE(PG8_SA(1, 1), a1 + hstepA, voffA); \
            PG8_WAIT_V(8); PG8_WAIT_L(0); PG8_BAR; if (HM != 2) { PG8_MMA(0, 0, At, B0); PG8_MMA(0, 1, At, B1); } PG8_BAR; PG8_SCHED; \
            if (HM != 1) PG8_LDA(At, 0, 1); PG8_STAGE(PG8_SB(0, 0), b2, voffB); PG8_STAGE(PG8_SB(0, 1), b2 + hstepB, voffB); PG8_STAGE(PG8_SA(0, 0), a2, voffA); \
            PG8_WAIT_V(8); PG8_WAIT_L(0); PG8_BAR; if (HM != 1) { PG8_MMA(1, 0, At, B0); PG8_MMA(1, 1, At, B1); } PG8_BAR; PG8_SCHED; \
            PG8_LDB(B0, 1, 0); PG8_LDB(B1, 1, 1); PG8_SCHED; if (HM != 2) PG8_LDA(At, 1, 0); PG8_STAGE(PG8_SA(0, 1), a2 + hstepA, voffA); \
            PG8_WAIT_V(8); PG8_WAIT_L(0); PG8_BAR; if (HM != 2) { PG8_MMA(0, 0, At, B0); PG8_MMA(0, 1, At, B1); } PG8_BAR; PG8_SCHED; \
            if (HM != 1) PG8_LDA(At, 1, 1); PG8_STAGE(PG8_SB(1, 0), b3, voffB); PG8_STAGE(PG8_SB(1, 1), b3 + hstepB, voffB); PG8_STAGE(PG8_SA(1, 0), a3, voffA); \
            PG8_WAIT_V(8); PG8_WAIT_L(0); PG8_BAR; if (HM != 1) { PG8_MMA(1, 0, At, B0); PG8_MMA(1, 1, At, B1); } PG8_BAR; PG8_SCHED; \
        }
        if constexpr (TAIL) { if (cur.hm == 0) { PG8_KLOOP(0) } else if (cur.hm == 1) { PG8_KLOOP(1) } else { PG8_KLOOP(2) } } else { PG8_KLOOP(0) }
#undef PG8_KLOOP
        if (wr == 0) PG8_BAR;
        if constexpr (SPLIT) { if (cur.ks >= 0) E.partial(acc, cur, wr, wc, fr, fq); else E(acc, cur, wr, wc, fr, fq); } else E(acc, cur, wr, wc, fr, fq);
        if (!has_next) break;
#pragma unroll
        for (int a = 0; a < 2; ++a)
#pragma unroll
            for (int b = 0; b < 2; ++b)
#pragma unroll
                for (int m = 0; m < 4; ++m)
#pragma unroll
                    for (int n = 0; n < 2; ++n) acc[a][b][m][n] = (f32x4){0.f, 0.f, 0.f, 0.f};
        cur = nxt; cA = nA; cB = nB; ++ui;
        if (wr == 1) PG8_BAR;
    }
    PG8_WAIT_V(0);
    PG8_BAR;
#undef PG8_SA
#undef PG8_SB
#undef PG8_STAGE
#undef PG8_LDA
#undef PG8_LDB
#undef PG8_MMA
#undef PG8_WAIT_V
#undef PG8_WAIT_L
#undef PG8_BAR
#undef PG8_SCHED
}
}

constexpr int NWAVES = 8, NTHREADS = 512;
constexpr int D = 2048, NB = 8, SEQ = 4096, CTXL = 256, DEPTH = 4, DFF = 5632;
constexpr int ML = NB * SEQ, MC = NB * CTXL, MT = ML + MC;
constexpr float EPS = 1e-6f;
constexpr int GLA_N = 6400;
constexpr int MLA_CN = 1280, MLA_QN = 3072, MLA_KVN = 4096;
constexpr int SWA_N = 2560;
constexpr int BIG_LD = 8448;

constexpr size_t MiB = 1u << 20;
constexpr size_t al256(size_t x) { return (x + 255) & ~(size_t)255; }
constexpr size_t WS_CTL = 0, CTL_ZERO_BYTES = 1 * MiB;
constexpr size_t WS_MOD = 1 * MiB;
constexpr size_t WS_ROPE = WS_MOD + al256((size_t)DEPTH * 9 * 6 * D * 4);
constexpr size_t WS_WF = WS_ROPE + al256((size_t)2 * SEQ * 32 * 4);
constexpr size_t WS_RSTD = WS_WF + 2 * 131072;
constexpr size_t WS_HCTX = WS_RSTD + al256((size_t)MT * 4);
constexpr size_t WS_WFFI = WS_HCTX + al256((size_t)MC * D * 4);
constexpr size_t SZ_WFFI = (size_t)2 * DFF * D * 2;
constexpr size_t WS_WFFO = WS_WFFI + 4 * SZ_WFFI;
constexpr size_t SZ_WFFO = (size_t)D * DFF * 2;
constexpr size_t WS_WGI = WS_WFFO + 4 * SZ_WFFO;
constexpr size_t SZ_WGI = (size_t)GLA_N * D * 2;
constexpr size_t WS_WGO = WS_WGI + 2 * SZ_WGI;
constexpr size_t SZ_WDD = (size_t)D * D * 2;
constexpr size_t WS_WMI = WS_WGO + 2 * SZ_WDD;
constexpr size_t WS_WMUQ = WS_WMI + (size_t)MLA_CN * D * 2;
constexpr size_t WS_WMUKV = WS_WMUQ + (size_t)MLA_QN * 512 * 2;
constexpr size_t WS_WMO = WS_WMUKV + (size_t)MLA_KVN * 512 * 2;
constexpr size_t WS_WSI = WS_WMO + SZ_WDD;
constexpr size_t WS_WSO = WS_WSI + (size_t)SWA_N * D * 2;
constexpr size_t WS_R1 = WS_WSO + SZ_WDD;
constexpr size_t WS_R2 = WS_R1 + (size_t)MT * D * 2;
constexpr size_t WS_BIG = WS_R2 + (size_t)MT * D * 2;
constexpr size_t WS_PART = WS_BIG + (size_t)MT * BIG_LD * 2;
constexpr size_t WS_GU = WS_PART + (size_t)4 * MC * D * 4;
constexpr size_t WS_END0 = WS_GU + (size_t)MT * 32 * 4;
constexpr size_t WS_END = WS_END0 > WS_PART + (size_t)NB * 4 * 2 * 68 * 74752 ? WS_END0 : WS_PART + (size_t)NB * 4 * 2 * 68 * 74752;
constexpr int CW_BAR = 4096;

constexpr int LDS_BYTES = 147456;
constexpr int LDSCTL_OFF = 146944;

#define GAS __attribute__((address_space(1)))
#define LAS __attribute__((address_space(3)))
typedef unsigned short bf16;
typedef unsigned v4u __attribute__((ext_vector_type(4)));
typedef unsigned v2u __attribute__((ext_vector_type(2)));
typedef float f32x4 __attribute__((ext_vector_type(4)));
#define LDS_WAIT() asm volatile("s_waitcnt lgkmcnt(0)" ::: "memory")
#define VM_WAIT() asm volatile("s_waitcnt vmcnt(0)" ::: "memory")
__device__ __forceinline__ unsigned f2bf(float f) { unsigned u = __builtin_bit_cast(unsigned, f); return (u + 0x7fffu + ((u >> 16) & 1u)) >> 16; }
__device__ __forceinline__ unsigned pk2(float lo, float hi) { return f2bf(lo) | (f2bf(hi) << 16); }
__device__ __forceinline__ float bflo(unsigned w) { return __builtin_bit_cast(float, w << 16); }
__device__ __forceinline__ float bfhi(unsigned w) { return __builtin_bit_cast(float, w & 0xffff0000u); }
__device__ __forceinline__ float bf2f(bf16 b) { return __builtin_bit_cast(float, (unsigned)b << 16); }
__device__ __forceinline__ float wave_sum(float v) {
#pragma unroll
    for (int o = 1; o < 64; o <<= 1) v += __shfl_xor(v, o);
    return v;
}

#define XB_TMO      128
#define XB_XCNT(j)  (256  + 64 * (j))
#define XB_XSUB(j)  (1280 + 64 * (j))
#define XB_XGEN(j)  (2304 + 64 * (j))
#define XB_TOP      3328
#define XB_TOPGEN   3392
#define XCD_BAR_WORDS 3456
#define XB_SPIN_CAP (1u << 22)
__device__ __forceinline__ unsigned xb_ld(unsigned* p)              { return __hip_atomic_load(p, __ATOMIC_RELAXED, __HIP_MEMORY_SCOPE_AGENT); }
__device__ __forceinline__ unsigned xb_add(unsigned* p, unsigned v) { return __hip_atomic_fetch_add(p, v, __ATOMIC_RELAXED, __HIP_MEMORY_SCOPE_AGENT); }
__device__ __forceinline__ unsigned xb_xcc_id() { return (unsigned)__builtin_amdgcn_s_getreg((3 << 11) | 20) & 0xFu; }
#define XB_SPIN(cond, bar) do { unsigned _sp = 0; while (cond) { __builtin_amdgcn_s_sleep(1); \
    if ((++_sp & 255u) == 0u) { if (xb_ld(&(bar)[XB_TMO])) break; if (_sp > XB_SPIN_CAP) { atomicAdd(&(bar)[XB_TMO], 1u); break; } } } } while (0)
struct XcdBarrier { unsigned* bar; unsigned x; volatile LAS unsigned* st; };
__device__ __forceinline__ XcdBarrier xcd_barrier_post(unsigned* bar, volatile LAS unsigned* st, bool leader) {
    XcdBarrier b; b.bar = bar; b.x = xb_xcc_id(); b.st = st;
    if (leader) (void)xb_add(&bar[XB_XCNT(b.x)], 1u);
    return b;
}
__device__ __forceinline__ void xcd_barrier_complete(unsigned* bar, unsigned x, unsigned& nloc, unsigned& nx) {
    const unsigned G = gridDim.x * gridDim.y * gridDim.z;
    unsigned sum, cnt, mine, sp = 0u;
    for (;;) {
        sum = 0u; cnt = 0u; mine = 0u;
#pragma unroll
        for (unsigned j = 0; j < 16; ++j) { const unsigned c = xb_ld(&bar[XB_XCNT(j)]); sum += c; cnt += (c > 0u) ? 1u : 0u; mine = (j == x) ? c : mine; }
        if (sum == G) break;
        __builtin_amdgcn_s_sleep(1);
        if ((++sp & 255u) == 0u) { if (xb_ld(&bar[XB_TMO])) break; if (sp > XB_SPIN_CAP) { atomicAdd(&bar[XB_TMO], 1u); break; } }
    }
    nloc = mine > 0u ? mine : 1u; nx = cnt > 0u ? cnt : 1u;
}
__device__ __forceinline__ void xcd_barrier(const XcdBarrier& b, bool leader) {
    asm volatile("s_waitcnt vmcnt(0)" ::: "memory");
    __syncthreads();
    if (leader) {
        unsigned* bar = b.bar;
        __builtin_amdgcn_s_waitcnt(0);
        unsigned nloc = b.st[0], nx = b.st[1];
        if (nloc == 0u) { xcd_barrier_complete(bar, b.x, nloc, nx); b.st[0] = nloc; b.st[1] = nx; }
        const unsigned old = xb_add(&bar[XB_XSUB(b.x)], 1u);
        const unsigned gen = old / nloc;
        if (old + 1u == (gen + 1u) * nloc) {
            __builtin_amdgcn_fence(__ATOMIC_RELEASE, "agent");
            asm volatile("s_waitcnt vmcnt(0)" ::: "memory");
            const unsigned og = xb_add(&bar[XB_TOP], 1u);
            const unsigned tg = og / nx;
            if (og + 1u == (tg + 1u) * nx) xb_add(&bar[XB_TOPGEN], 1u);
            else XB_SPIN(xb_ld(&bar[XB_TOPGEN]) == tg, bar);
            __builtin_amdgcn_fence(__ATOMIC_ACQUIRE, "agent");
            xb_add(&bar[XB_XGEN(b.x)], 1u);
            asm volatile("s_waitcnt vmcnt(0)" ::: "memory");
        } else {
            XB_SPIN(xb_ld(&bar[XB_XGEN(b.x)]) == gen, bar);
            __builtin_amdgcn_fence(__ATOMIC_ACQUIRE, "agent");
            asm volatile("s_waitcnt vmcnt(0)" ::: "memory");
        }
    }
    __syncthreads();
}

struct Args { const float* in[24]; float* out; unsigned char* ws; int ph_lo, ph_hi; };
struct Frame {
    LAS unsigned char* lds;
    int tid, lane, wave, G, bid, vb;
};
__device__ __forceinline__ Frame relaunder(const Frame& F0) {
    Frame F = F0; int wv = F0.wave; asm volatile("" : "+s"(wv)); F.wave = wv; F.lane = hw_lane(); F.tid = wv * 64 + F.lane;
    int g = F0.G, b = F0.bid; asm volatile("" : "+s"(g), "+s"(b)); F.G = g; F.bid = b; F.vb = (g % 8 == 0) ? (b % 8) * (g / 8) + b / 8 : b; return F;
}
typedef __attribute__((address_space(1))) unsigned char gbyte;
__device__ __forceinline__ const float* inp(const Args& P, int i) { const float* p = P.in[i]; asm volatile("" : "+s"(p)); return p; }
__device__ __forceinline__ gbyte* wsp(const Args& P) { unsigned char* p = P.ws; asm volatile("" : "+s"(p)); return (gbyte*)p; }
enum { I_X = 0, I_C, I_CTX, I_CCTX, I_WADA, I_BADA, I_GNORM, I_WFFI, I_WFFO, I_GWIN, I_GWGD, I_GWGU, I_GBG, I_GGH, I_GWO,
       I_MWIN, I_MGQ, I_MWUQ, I_MGKV, I_MWUKV, I_MWO, I_SWIN, I_SSINK, I_SWO };

__device__ __forceinline__ bf16* hrow_b(const Frame& F, const Args& P, int row) { return row < ML ? (bf16*)((gbyte*)P.out + (size_t)row * (D * 4) + D * 2) : (bf16*)(wsp(P) + WS_HCTX + (size_t)(row - ML) * (D * 4) + D * 2); }
__device__ __forceinline__ const float* hrow_in(const Frame& F, const Args& P, int row) { return row < ML ? inp(P, I_X) + (size_t)row * D : inp(P, I_CTX) + (size_t)(row - ML) * D; }
__device__ __forceinline__ int row_cond(int row) { return row < ML ? (row >> 12) : 8; }
__device__ __forceinline__ const float* modp(const Frame& F, const Args& P, int L, int r, int slot) { return (const float*)(wsp(P) + WS_MOD) + ((size_t)(L * 9 + r) * 6 + slot) * D; }

__device__ __forceinline__ void mod_item(const Frame& F, const Args& P, int it) {
    const int L = it / 192, col0 = (it % 192) * 64;
    LAS float* cs = (LAS float*)F.lds;
    __syncthreads();
    for (int i = F.tid; i < 9 * D; i += NTHREADS) { const int r = i / D, k = i % D; const float c = (r < 8) ? inp(P, I_C)[r * D + k] : inp(P, I_CCTX)[k]; cs[k * 12 + r] = c * __builtin_amdgcn_rcpf(1.0f + __expf(-c)); }
    __syncthreads();
    const int cg = F.tid & 15, kg = F.tid >> 4;
    const float* W = inp(P, I_WADA) + (size_t)L * D * (6 * D) + col0 + 4 * cg;
    float acc[9][4];
#pragma unroll
    for (int r = 0; r < 9; ++r) { acc[r][0] = 0.f; acc[r][1] = 0.f; acc[r][2] = 0.f; acc[r][3] = 0.f; }
#pragma unroll 16
    for (int kk = 0; kk < 64; ++kk) { const int k = kg * 64 + kk;
        const f32x4 w = *(const f32x4*)(W + (size_t)k * (6 * D));
        const f32x4 s0 = *(const LAS f32x4*)(cs + k * 12), s1 = *(const LAS f32x4*)(cs + k * 12 + 4); const float s8 = cs[k * 12 + 8];
#pragma unroll
        for (int j = 0; j < 4; ++j) { acc[0][j] += s0[0] * w[j]; acc[1][j] += s0[1] * w[j]; acc[2][j] += s0[2] * w[j]; acc[3][j] += s0[3] * w[j];
            acc[4][j] += s1[0] * w[j]; acc[5][j] += s1[1] * w[j]; acc[6][j] += s1[2] * w[j]; acc[7][j] += s1[3] * w[j]; acc[8][j] += s8 * w[j]; } }
    __syncthreads();
    LAS float* red = (LAS float*)F.lds;
#pragma unroll
    for (int r = 0; r < 9; ++r) *(LAS f32x4*)(red + (kg * 9 + r) * 64 + 4 * cg) = (f32x4){acc[r][0], acc[r][1], acc[r][2], acc[r][3]};
    __syncthreads();
    for (int o = F.tid; o < 9 * 64; o += NTHREADS) { const int r = o / 64, c = o % 64; float s = 0.f;
        for (int g = 0; g < 32; ++g) s += red[(g * 9 + r) * 64 + c];
        ((float*)(wsp(P) + WS_MOD))[(size_t)(L * 9 + r) * (6 * D) + col0 + c] = s + inp(P, I_BADA)[L * (6 * D) + col0 + c]; }
}
__device__ __forceinline__ void rope_item(const Frame& F, const Args& P, int it) {
    const int e = it * NTHREADS + F.tid;
    const int t = e >> 5, f = e & 31; const int pos = (f < 16) ? (t >> 6) : (t & 63);
    const float inv = powf(10000.0f, -(float)(f & 15) / 16.0f); const float ang = (float)pos * inv;
    float* rt = (float*)(wsp(P) + WS_ROPE); rt[e] = cosf(ang); rt[SEQ * 32 + e] = sinf(ang);
}
template <int MODE>
__device__ __forceinline__ void cvt_item(const float* W, int ldw, int k0, int srccol0, bf16* WT, int ldt, int dstrow0, float scale, const float* kscale, LAS float* scr, int lane, const float* gu) {
    if (MODE == 2) {
#pragma unroll 8
        for (int kk = 0; kk < 64; ++kk) scr[kk * 65 + lane] = (lane < 32) ? W[((size_t)(lane >> 4) * D + k0 + kk) * 16 + (lane & 15)] : 0.f;
    } else if (MODE == 1) {
#pragma unroll 8
        for (int kk = 0; kk < 64; ++kk) scr[kk * 65 + lane] = 0.f;
    } else {
        const float* wp = W + (size_t)k0 * ldw + srccol0 + lane;
        float v[64];
#pragma unroll
        for (int kk = 0; kk < 64; ++kk) v[kk] = wp[(size_t)kk * ldw];
        if (kscale) {
#pragma unroll
            for (int kk = 0; kk < 64; ++kk) v[kk] *= kscale[k0 + kk];
        }
#pragma unroll
        for (int kk = 0; kk < 64; ++kk) scr[kk * 65 + lane] = v[kk] * scale;
    }
    LDS_WAIT(); asm volatile("" ::: "memory");
    const int c = lane & 7;
#pragma unroll
    for (int j = 0; j < 8; ++j) { const int nn = (lane >> 3) + 8 * j; const LAS float* sp = scr + (8 * c) * 65 + nn;
        v4u o; o.x = pk2(sp[0 * 65], sp[1 * 65]); o.y = pk2(sp[2 * 65], sp[3 * 65]); o.z = pk2(sp[4 * 65], sp[5 * 65]); o.w = pk2(sp[6 * 65], sp[7 * 65]);
        *(v4u*)(WT + (size_t)(dstrow0 + nn) * ldt + k0 + 8 * c) = o; }
    LDS_WAIT(); asm volatile("" ::: "memory");
}
__device__ __forceinline__ void prologue(const Frame& F0, const Args& P) {
    const Frame F = relaunder(F0);
    for (int it = F.bid; it < 768 + 256 + 32; it += F.G) {
        if (it < 768) mod_item(F, P, it); else if (it < 1024) rope_item(F, P, it - 768);
        else { const int f = (it - 1024) * NTHREADS + F.tid, jl = f >> 13, ff = f & 8191;
            const int dt = ff >> 6, l = ff & 63, m = l & 15, q = l >> 4, dir = dt >> 6, c = (dt & 63) * 16 + m; const float* gu = inp(P, I_GWGU) + (size_t)jl * 2 * 16 * 1024;
            float v[8];
#pragma unroll
            for (int jj = 0; jj < 8; ++jj) { const int k = 8 * q + jj; v[jj] = ((k >> 4) == dir) ? gu[(size_t)(dir * 16 + (k & 15)) * 1024 + c] : 0.f; }
            *(v4u*)(wsp(P) + WS_WF + (size_t)f * 16) = (v4u){pk2(v[0], v[1]), pk2(v[2], v[3]), pk2(v[4], v[5]), pk2(v[6], v[7])}; }
    }
    __syncthreads();
    LAS float* scr = (LAS float*)(F.lds + F.wave * 16640);
    const int gw = F.bid * NWAVES + F.wave, NGW = F.G * NWAVES;
    constexpr int I_FFI = 32 * 176, I_FFO = 88 * 32, I_GI = 32 * 100, I_DD = 32 * 32, I_MI = 32 * 20, I_MUQ = 8 * 48, I_MUKV = 8 * 64, I_SI = 32 * 40;
    constexpr int NITEMS = 4 * I_FFI + 4 * I_FFO + 2 * I_GI + 2 * I_DD + I_MI + I_MUQ + I_MUKV + I_DD + I_SI + I_DD;
    for (int it = gw; it < NITEMS; it += NGW) {
        int r = it;
        const float* W = nullptr; const float* ks = nullptr; const float* gu = nullptr; bf16* WT; int ldw = 0, k0, src = 0, ldt, drow; float sc = 1.f; int mode = 0;
        if (r < 4 * I_FFI) { const int L = r / I_FFI; r %= I_FFI; const int kb = r / 176, nb = r % 176, p0 = nb * 64, pn = p0 >> 8, j = p0 & 255;
            src = (j < 128) ? pn * 128 + j : DFF + pn * 128 + (j - 128);
            W = inp(P, I_WFFI) + (size_t)L * D * 2 * DFF; ldw = 2 * DFF; k0 = kb * 64; WT = (bf16*)(wsp(P) + WS_WFFI + L * SZ_WFFI); ldt = D; drow = p0; }
        else if ((r -= 4 * I_FFI) < 4 * I_FFO) { const int L = r / I_FFO; r %= I_FFO; const int kb = r / 32, nb = r % 32;
            W = inp(P, I_WFFO) + (size_t)L * DFF * D; ldw = D; k0 = kb * 64; src = nb * 64; WT = (bf16*)(wsp(P) + WS_WFFO + L * SZ_WFFO); ldt = DFF; drow = nb * 64; }
        else if ((r -= 4 * I_FFO) < 2 * I_GI) { const int j = r / I_GI; r %= I_GI; const int kb = r / 100, nb = r % 100, p0 = nb * 64; WT = (bf16*)(wsp(P) + WS_WGI + j * SZ_WGI); ldt = D; drow = p0; k0 = kb * 64;
            if (p0 < 6144) { W = inp(P, I_GWIN) + (size_t)j * D * 6144; ldw = 6144; src = p0; sc = p0 < 1024 ? 0.0625f : 1.f; }
            else if (p0 == 6144) { mode = 2; W = inp(P, I_GWGD) + (size_t)j * 2 * D * 16; }
            else mode = 1; }
        else if ((r -= 2 * I_GI) < 2 * I_DD) { const int j = r / I_DD; r %= I_DD; const int kb = r / 32, nb = r % 32;
            W = inp(P, I_GWO) + (size_t)j * D * D; ldw = D; k0 = kb * 64; src = nb * 64; WT = (bf16*)(wsp(P) + WS_WGO + j * SZ_WDD); ldt = D; drow = nb * 64; }
        else if ((r -= 2 * I_DD) < I_MI) { const int kb = r / 20, nb = r % 20; k0 = kb * 64; WT = (bf16*)(wsp(P) + WS_WMI); ldt = D; drow = nb * 64;
            if (nb < 17) { W = inp(P, I_MWIN); ldw = 1088; src = nb * 64; } else mode = 1; }
        else if ((r -= I_MI) < I_MUQ) { const int kb = r / 48, nb = r % 48; W = inp(P, I_MWUQ); ldw = MLA_QN; k0 = kb * 64; src = nb * 64; WT = (bf16*)(wsp(P) + WS_WMUQ); ldt = 512; drow = nb * 64; ks = inp(P, I_MGQ); }
        else if ((r -= I_MUQ) < I_MUKV) { const int kb = r / 64, nb = r % 64; W = inp(P, I_MWUKV); ldw = MLA_KVN; k0 = kb * 64; src = nb * 64; WT = (bf16*)(wsp(P) + WS_WMUKV); ldt = 512; drow = nb * 64; ks = inp(P, I_MGKV); }
        else if ((r -= I_MUKV) < I_DD) { const int kb = r / 32, nb = r % 32; W = inp(P, I_MWO); ldw = D; k0 = kb * 64; src = nb * 64; WT = (bf16*)(wsp(P) + WS_WMO); ldt = D; drow = nb * 64; }
        else if ((r -= I_DD) < I_SI) { const int kb = r / 40, nb = r % 40; W = inp(P, I_SWIN); ldw = SWA_N; k0 = kb * 64; src = nb * 64; WT = (bf16*)(wsp(P) + WS_WSI); ldt = D; drow = nb * 64; }
        else { r -= I_SI; const int kb = r / 32, nb = r % 32; W = inp(P, I_SWO); ldw = D; k0 = kb * 64; src = nb * 64; WT = (bf16*)(wsp(P) + WS_WSO); ldt = D; drow = nb * 64; }
        if (mode == 2) cvt_item<2>(W, 16, k0, src, WT, ldt, drow, 1.f, nullptr, scr, F.lane, gu);
        else if (mode == 1) cvt_item<1>(nullptr, 0, k0, 0, WT, ldt, drow, 1.f, nullptr, scr, F.lane, nullptr);
        else cvt_item<0>(W, ldw, k0, src, WT, ldt, drow, sc, ks, scr, F.lane, nullptr);
    }
}

template <int NR>
__device__ __forceinline__ void row_stage01(const Frame& F, const Args& P, int L, int stage, int row0, int rstep) {
    const LAS float* V0 = (const LAS float*)F.lds; const LAS float* V2 = V0 + 2 * D; const LAS float* V3 = V0 + 3 * D;
    bf16* Y = (bf16*)(wsp(P) + WS_R2); bf16* A = (bf16*)(wsp(P) + WS_R1); float* RS = (float*)(wsp(P) + WS_RSTD);
    f32x4 h[NR][8], y[NR][8];
#pragma unroll
    for (int n = 0; n < NR; ++n) { const int row = row0 + n * rstep;
        if (stage == 0) { const float* hin = hrow_in(F, P, row); bf16* hb = hrow_b(F, P, row);
#pragma unroll
            for (int j = 0; j < 8; ++j) { h[n][j] = ((const f32x4*)hin)[F.lane + 64 * j]; v2u w; w.x = pk2(h[n][j][0], h[n][j][1]); w.y = pk2(h[n][j][2], h[n][j][3]);
                ((v2u*)hb)[F.lane + 64 * j] = w; } }
        else { const bf16* hb = hrow_b(F, P, row);
#pragma unroll
            for (int j = 0; j < 8; ++j) { const v2u w = ((const v2u*)hb)[F.lane + 64 * j]; h[n][j] = (f32x4){bflo(w.x), bfhi(w.x), bflo(w.y), bfhi(w.y)}; } }
        if (stage == 1) {
#pragma unroll
            for (int j = 0; j < 8; ++j) {
                if (row < ML) { const v2u w = ((const v2u*)(Y + (size_t)row * D))[F.lane + 64 * j]; y[n][j] = (f32x4){bflo(w.x), bfhi(w.x), bflo(w.y), bfhi(w.y)}; }
                else { const f32x4* pp = (const f32x4*)((const float*)(wsp(P) + WS_PART) + (size_t)(row - ML) * D) + F.lane + 64 * j;
                    y[n][j] = (pp[0] + pp[(size_t)MC * D / 4]) + (pp[(size_t)2 * MC * D / 4] + pp[(size_t)3 * MC * D / 4]); } }
        }
    }
#pragma unroll
    for (int n = 0; n < NR; ++n) { const int row = row0 + n * rstep;
        if (stage == 1) {
            if (row >= ML) {
#pragma unroll
                for (int j = 0; j < 8; ++j) { v2u w; w.x = pk2(y[n][j][0], y[n][j][1]); w.y = pk2(y[n][j][2], y[n][j][3]); ((v2u*)(Y + (size_t)row * D))[F.lane + 64 * j] = w;
                    y[n][j] = (f32x4){bflo(w.x), bfhi(w.x), bflo(w.y), bfhi(w.y)}; }
            }
            float ss = 0.f;
#pragma unroll
            for (int j = 0; j < 8; ++j) ss += (y[n][j][0] * y[n][j][0] + y[n][j][1] * y[n][j][1]) + (y[n][j][2] * y[n][j][2] + y[n][j][3] * y[n][j][3]);
            const float rstd = __builtin_amdgcn_rsqf(wave_sum(ss) * (1.0f / D) + EPS);
            if (F.lane == 0) RS[row] = rstd;
#pragma unroll
            for (int j = 0; j < 8; ++j) { const f32x4 w0 = *(const LAS f32x4*)(V0 + 4 * (F.lane + 64 * j)); h[n][j] = h[n][j] + w0 * (y[n][j] * rstd); }
        }
        float ss = 0.f;
#pragma unroll
        for (int j = 0; j < 8; ++j) ss += (h[n][j][0] * h[n][j][0] + h[n][j][1] * h[n][j][1]) + (h[n][j][2] * h[n][j][2] + h[n][j][3] * h[n][j][3]);
        const float rstd = __builtin_amdgcn_rsqf(wave_sum(ss) * (1.0f / D) + EPS);
#pragma unroll
        for (int j = 0; j < 8; ++j) { const f32x4 w1 = *(const LAS f32x4*)(V2 + 4 * (F.lane + 64 * j)), w2 = *(const LAS f32x4*)(V3 + 4 * (F.lane + 64 * j));
            const f32x4 a = (h[n][j] * rstd) * w1 + w2; v2u w; w.x = pk2(a[0], a[1]); w.y = pk2(a[2], a[3]);
            ((v2u*)(A + (size_t)row * D))[F.lane + 64 * j] = w; }
    }
}
template <int NR>
__device__ __forceinline__ void row_stage2(const Frame& F, const Args& P, int L, bool want_a, int row0, int rstep) {
    const LAS float* V0 = (const LAS float*)F.lds; const LAS float* V1 = V0 + D; const LAS float* V2 = V0 + 2 * D; const LAS float* V3 = V0 + 3 * D;
    const bf16* Y = (const bf16*)(wsp(P) + WS_R2); bf16* FA = (bf16*)(wsp(P) + WS_R1); const float* RS = (const float*)(wsp(P) + WS_RSTD);
    f32x4 h[NR][8], f[NR][8]; v2u yp[NR][8]; float rsy[NR];
#pragma unroll
    for (int n = 0; n < NR; ++n) { const int row = row0 + n * rstep;
        { const bf16* hb = hrow_b(F, P, row);
#pragma unroll
            for (int j = 0; j < 8; ++j) { const v2u w = ((const v2u*)hb)[F.lane + 64 * j]; h[n][j] = (f32x4){bflo(w.x), bfhi(w.x), bflo(w.y), bfhi(w.y)}; } }
#pragma unroll
        for (int j = 0; j < 8; ++j) yp[n][j] = ((const v2u*)(Y + (size_t)row * D))[F.lane + 64 * j];
        rsy[n] = RS[row];
#pragma unroll
        for (int j = 0; j < 8; ++j) {
            if (row < ML) { const v2u w = ((const v2u*)(FA + (size_t)row * D))[F.lane + 64 * j]; f[n][j] = (f32x4){bflo(w.x), bfhi(w.x), bflo(w.y), bfhi(w.y)}; }
            else { const f32x4* pp = (const f32x4*)((const float*)(wsp(P) + WS_PART) + (size_t)(row - ML) * D) + F.lane + 64 * j;
                f[n][j] = (pp[0] + pp[(size_t)MC * D / 4]) + (pp[(size_t)2 * MC * D / 4] + pp[(size_t)3 * MC * D / 4]); } }
    }
    const bool last = (L == DEPTH - 1);
    if (last) asm volatile("s_waitcnt vmcnt(0)" ::: "memory");
#pragma unroll
    for (int n = 0; n < NR; ++n) { const int row = row0 + n * rstep;
        float ss = 0.f;
#pragma unroll
        for (int j = 0; j < 8; ++j) ss += (f[n][j][0] * f[n][j][0] + f[n][j][1] * f[n][j][1]) + (f[n][j][2] * f[n][j][2] + f[n][j][3] * f[n][j][3]);
        const float rstd_f = __builtin_amdgcn_rsqf(wave_sum(ss) * (1.0f / D) + EPS);
        float* hout = (float*)((gbyte*)P.out + (size_t)row * (D * 4)); bf16* hbo = hrow_b(F, P, row);
#pragma unroll
        for (int j = 0; j < 8; ++j) { const f32x4 w0 = *(const LAS f32x4*)(V0 + 4 * (F.lane + 64 * j)), w1 = *(const LAS f32x4*)(V1 + 4 * (F.lane + 64 * j));
            const f32x4 yv = (f32x4){bflo(yp[n][j].x), bfhi(yp[n][j].x), bflo(yp[n][j].y), bfhi(yp[n][j].y)};
            h[n][j] = h[n][j] + w0 * (yv * rsy[n]);
            h[n][j] = h[n][j] + w1 * (f[n][j] * rstd_f);
            if (last) ((f32x4*)hout)[F.lane + 64 * j] = h[n][j];
            else { v2u w; w.x = pk2(h[n][j][0], h[n][j][1]); w.y = pk2(h[n][j][2], h[n][j][3]); ((v2u*)hbo)[F.lane + 64 * j] = w; } }
        if (want_a) {
            float s2 = 0.f;
#pragma unroll
            for (int j = 0; j < 8; ++j) s2 += (h[n][j][0] * h[n][j][0] + h[n][j][1] * h[n][j][1]) + (h[n][j][2] * h[n][j][2] + h[n][j][3] * h[n][j][3]);
            const float rstd = __builtin_amdgcn_rsqf(wave_sum(s2) * (1.0f / D) + EPS);
#pragma unroll
            for (int j = 0; j < 8; ++j) { const f32x4 w2 = *(const LAS f32x4*)(V2 + 4 * (F.lane + 64 * j)), w3 = *(const LAS f32x4*)(V3 + 4 * (F.lane + 64 * j));
                const f32x4 a = (h[n][j] * rstd) * w2 + w3; v2u w; w.x = pk2(a[0], a[1]); w.y = pk2(a[2], a[3]);
                ((v2u*)(FA + (size_t)row * D))[F.lane + 64 * j] = w; }
        }
    }
}
struct RowRaw { v2u h[8]; v2u y[8]; v2u f[8]; float rsy; };
__device__ __forceinline__ f32x4 unpk4(const v2u w) { return (f32x4){bflo(w.x), bfhi(w.x), bflo(w.y), bfhi(w.y)}; }
template <int STAGE>
__device__ __forceinline__ void rowraw_load(RowRaw& R, const Frame& F, const Args& P, int row) {
    const bf16* hb = hrow_b(F, P, row); const bf16* Y = (const bf16*)(wsp(P) + WS_R2);
#pragma unroll
    for (int j = 0; j < 8; ++j) R.h[j] = ((const v2u*)hb)[F.lane + 64 * j];
#pragma unroll
    for (int j = 0; j < 8; ++j) R.y[j] = ((const v2u*)(Y + (size_t)row * D))[F.lane + 64 * j];
    if (STAGE == 2) { const bf16* FA = (const bf16*)(wsp(P) + WS_R1);
#pragma unroll
        for (int j = 0; j < 8; ++j) R.f[j] = ((const v2u*)(FA + (size_t)row * D))[F.lane + 64 * j];
        R.rsy = ((const float*)(wsp(P) + WS_RSTD))[row]; }
}
template <int STAGE, bool LAST>
__device__ __forceinline__ void rowraw_compute(const RowRaw& cur, const Frame& F, const Args& P, int row) {
    const LAS float* V0 = (const LAS float*)F.lds; const LAS float* V1 = V0 + D; const LAS float* V2 = V0 + 2 * D; const LAS float* V3 = V0 + 3 * D;
    bf16* A = (bf16*)(wsp(P) + WS_R1); float* RS = (float*)(wsp(P) + WS_RSTD);
    if (LAST) asm volatile("s_waitcnt vmcnt(0)" ::: "memory");
    f32x4 h[8];
#pragma unroll
    for (int j = 0; j < 8; ++j) h[j] = unpk4(cur.h[j]);
    if (STAGE == 1) {
        float ss = 0.f;
#pragma unroll
        for (int j = 0; j < 8; ++j) { const f32x4 y = unpk4(cur.y[j]); ss += (y[0] * y[0] + y[1] * y[1]) + (y[2] * y[2] + y[3] * y[3]); }
        const float rstd_y = __builtin_amdgcn_rsqf(wave_sum(ss) * (1.0f / D) + EPS);
        if (F.lane == 0) RS[row] = rstd_y;
#pragma unroll
        for (int j = 0; j < 8; ++j) { const f32x4 w0 = *(const LAS f32x4*)(V0 + 4 * (F.lane + 64 * j)); h[j] = h[j] + w0 * (unpk4(cur.y[j]) * rstd_y); }
    } else {
        float ss = 0.f;
#pragma unroll
        for (int j = 0; j < 8; ++j) { const f32x4 f = unpk4(cur.f[j]); ss += (f[0] * f[0] + f[1] * f[1]) + (f[2] * f[2] + f[3] * f[3]); }
        const float rstd_f = __builtin_amdgcn_rsqf(wave_sum(ss) * (1.0f / D) + EPS);
        float* hout = (float*)((gbyte*)P.out + (size_t)row * (D * 4)); bf16* hbo = hrow_b(F, P, row);
#pragma unroll
        for (int j = 0; j < 8; ++j) { const f32x4 w0 = *(const LAS f32x4*)(V0 + 4 * (F.lane + 64 * j)), w1 = *(const LAS f32x4*)(V1 + 4 * (F.lane + 64 * j));
            h[j] = h[j] + w0 * (unpk4(cur.y[j]) * cur.rsy);
            h[j] = h[j] + w1 * (unpk4(cur.f[j]) * rstd_f);
            if (LAST) ((f32x4*)hout)[F.lane + 64 * j] = h[j];
            else { v2u w; w.x = pk2(h[j][0], h[j][1]); w.y = pk2(h[j][2], h[j][3]); ((v2u*)hbo)[F.lane + 64 * j] = w; } }
    }
    if (!LAST) {
        float s2 = 0.f;
#pragma unroll
        for (int j = 0; j < 8; ++j) s2 += (h[j][0] * h[j][0] + h[j][1] * h[j][1]) + (h[j][2] * h[j][2] + h[j][3] * h[j][3]);
        const float rstd = __builtin_amdgcn_rsqf(wave_sum(s2) * (1.0f / D) + EPS);
#pragma unroll
        for (int j = 0; j < 8; ++j) { const f32x4 w2 = *(const LAS f32x4*)(V2 + 4 * (F.lane + 64 * j)), w3 = *(const LAS f32x4*)(V3 + 4 * (F.lane + 64 * j));
            const f32x4 a = (h[j] * rstd) * w2 + w3; v2u w; w.x = pk2(a[0], a[1]); w.y = pk2(a[2], a[3]);
            ((v2u*)(A + (size_t)row * D))[F.lane + 64 * j] = w; }
    }
}
template <int STAGE, bool LAST>
__device__ __forceinline__ void row_lat_pipe(const Frame& F, const Args& P, int row0) {
    RowRaw ra, rb;
    rowraw_load<STAGE>(ra, F, P, row0);
    for (int k = 0; k < 7; ++k) { const int row = row0 + 16 * k;
        rowraw_load<STAGE>(rb, F, P, row + 8);  rowraw_compute<STAGE, LAST>(ra, F, P, row);
        rowraw_load<STAGE>(ra, F, P, row + 16); rowraw_compute<STAGE, LAST>(rb, F, P, row + 8); }
    rowraw_load<STAGE>(rb, F, P, row0 + 120); rowraw_compute<STAGE, LAST>(ra, F, P, row0 + 112);
    rowraw_compute<STAGE, LAST>(rb, F, P, row0 + 120);
}
struct RowRaw0 { f32x4 h[8]; };
__device__ __forceinline__ void rowraw0_load(RowRaw0& R, const Frame& F, const Args& P, int row) {
    const float* hin = hrow_in(F, P, row);
#pragma unroll
    for (int j = 0; j < 8; ++j) R.h[j] = ((const f32x4*)hin)[F.lane + 64 * j];
}
__device__ __forceinline__ void rowraw0_compute(const RowRaw0& cur, const Frame& F, const Args& P, int row) {
    const LAS float* V2 = (const LAS float*)F.lds + 2 * D; const LAS float* V3 = (const LAS float*)F.lds + 3 * D;
    bf16* A = (bf16*)(wsp(P) + WS_R1); bf16* hb = hrow_b(F, P, row);
    float ss = 0.f;
#pragma unroll
    for (int j = 0; j < 8; ++j) { const f32x4 h = cur.h[j]; v2u w; w.x = pk2(h[0], h[1]); w.y = pk2(h[2], h[3]); ((v2u*)hb)[F.lane + 64 * j] = w;
        ss += (h[0] * h[0] + h[1] * h[1]) + (h[2] * h[2] + h[3] * h[3]); }
    const float rstd = __builtin_amdgcn_rsqf(wave_sum(ss) * (1.0f / D) + EPS);
#pragma unroll
    for (int j = 0; j < 8; ++j) { const f32x4 w2 = *(const LAS f32x4*)(V2 + 4 * (F.lane + 64 * j)), w3 = *(const LAS f32x4*)(V3 + 4 * (F.lane + 64 * j));
        const f32x4 a = (cur.h[j] * rstd) * w2 + w3; v2u w; w.x = pk2(a[0], a[1]); w.y = pk2(a[2], a[3]);
        ((v2u*)(A + (size_t)row * D))[F.lane + 64 * j] = w; }
}
__device__ __forceinline__ void row_lat_pipe0(const Frame& F, const Args& P, int row0) {
    RowRaw0 ra, rb;
    rowraw0_load(ra, F, P, row0);
    for (int k = 0; k < 7; ++k) { const int row = row0 + 16 * k;
        rowraw0_load(rb, F, P, row + 8);  rowraw0_compute(ra, F, P, row);
        rowraw0_load(ra, F, P, row + 16); rowraw0_compute(rb, F, P, row + 8); }
    rowraw0_load(rb, F, P, row0 + 120); rowraw0_compute(ra, F, P, row0 + 112);
    rowraw0_compute(rb, F, P, row0 + 120);
}
__device__ __forceinline__ void row_pass(const Frame& F0, const Args& P, int L, int stage) {
    const Frame F = relaunder(F0);
    LAS float* V = (LAS float*)F.lds;
    const bool want_a = !(stage == 2 && L == DEPTH - 1), do_ctx = !(L == DEPTH - 1 && stage > 0);
    const float* gn = inp(P, I_GNORM);
    for (int part = 0; part < (do_ctx ? 2 : 1); ++part) {
        for (int c = F.bid; c < 256; c += F.G) {
            const int r = part == 0 ? (c >> 5) : 8;
            __syncthreads();
            { const int e = 4 * F.tid;
              if (stage > 0) { const f32x4 gt = *(const f32x4*)(modp(F, P, L, r, 2) + e), gg = *(const f32x4*)(gn + (size_t)(L * 4 + 1) * D + e); *(LAS f32x4*)(V + e) = gt * gg; }
              if (stage == 2) { const f32x4 gt = *(const f32x4*)(modp(F, P, L, r, 5) + e), gg = *(const f32x4*)(gn + (size_t)(L * 4 + 3) * D + e); *(LAS f32x4*)(V + D + e) = gt * gg; }
              if (want_a) { const int La = (stage == 2) ? L + 1 : L, sl = (stage == 1) ? 3 : 0;
                  const f32x4 sh = *(const f32x4*)(modp(F, P, La, r, sl) + e), sc = *(const f32x4*)(modp(F, P, La, r, sl + 1) + e), gg = *(const f32x4*)(gn + (size_t)(La * 4 + (stage == 1 ? 2 : 0)) * D + e);
                  *(LAS f32x4*)(V + 2 * D + e) = gg * (sc + 1.0f); *(LAS f32x4*)(V + 3 * D + e) = sh; } }
            __syncthreads();
            if (stage < 2) {
                if (part == 0) { if (stage == 0) row_lat_pipe0(F, P, c * 128 + F.wave); else row_lat_pipe<1, false>(F, P, c * 128 + F.wave); }
                else row_stage01<1>(F, P, L, stage, ML + c * 8 + F.wave, 0);
            } else {
                if (part == 0) { if (L == DEPTH - 1) row_lat_pipe<2, true>(F, P, c * 128 + F.wave); else row_lat_pipe<2, false>(F, P, c * 128 + F.wave); }
                else row_stage2<1>(F, P, L, want_a, ML + c * 8 + F.wave, 0);
            }
        }
    }
}

__device__ __forceinline__ void gla_gate(const Frame& F0, const Args& P, int L) {
    typedef short bf16x8_t __attribute__((ext_vector_type(8)));
    const Frame F = relaunder(F0);
    const int j = L / 3, lane = F.lane, n16 = lane & 15, q4 = lane >> 4;
    bf16x8_t af[16]; f32x4 bv[16];
    { const v4u* src = (const v4u*)(wsp(P) + WS_WF + (size_t)j * 131072); const float* gb = inp(P, I_GBG) + j * 2048;
#pragma unroll
      for (int t = 0; t < 16; ++t) { const int dt = F.wave * 16 + t; af[t] = __builtin_bit_cast(bf16x8_t, src[dt * 64 + lane]); bv[t] = *(const f32x4*)(gb + 16 * dt + 4 * q4); } }
    const float* U = (const float*)(wsp(P) + WS_GU); bf16* X = (bf16*)(wsp(P) + WS_BIG);
#define GG_LOAD(u0, u1, g) { const float* up = U + (size_t)(16 * (g) + n16) * 32 + 8 * q4; u0 = *(const f32x4*)up; u1 = *(const f32x4*)(up + 4); }
#define GG_BODY(u0, u1, g) { \
        const v4u bw = {pk2(u0[0], u0[1]), pk2(u0[2], u0[3]), pk2(u1[0], u1[1]), pk2(u1[2], u1[3])}; \
        const bf16x8_t bfr = __builtin_bit_cast(bf16x8_t, bw); \
        bf16* xr = X + (size_t)(16 * (g) + n16) * BIG_LD + 6144 + 256 * F.wave + 4 * q4; \
        _Pragma("unroll") for (int t = 0; t < 16; ++t) { \
            f32x4 z = __builtin_amdgcn_mfma_f32_16x16x32_bf16(af[t], bfr, bv[t], 0, 0, 0);     \
            v2u w; w.x = pk2(pg8::logsig16(z[0]), pg8::logsig16(z[1])); w.y = pk2(pg8::logsig16(z[2]), pg8::logsig16(z[3])); \
            *(v2u*)(xr + 16 * t) = w; } }
    constexpr int NG = MT / 16;
    int g = F.bid; f32x4 a0, a1, b0, b1;
    if (g < NG) GG_LOAD(a0, a1, g);
    while (g < NG) {
        const int g2 = g + F.G; if (g2 < NG) GG_LOAD(b0, b1, g2);
        GG_BODY(a0, a1, g);
        if (g2 >= NG) break;
        const int g3 = g2 + F.G; if (g3 < NG) GG_LOAD(a0, a1, g3);
        GG_BODY(b0, b1, g2);
        g = g3;
    }
#undef GG_LOAD
#undef GG_BODY
}

namespace gsc {
typedef short bf16x8 __attribute__((ext_vector_type(8)));
typedef short s16x4 __attribute__((ext_vector_type(4)));
typedef float f32x4 __attribute__((ext_vector_type(4)));
typedef float f32x2 __attribute__((ext_vector_type(2)));
typedef __bf16 bf16x2_t __attribute__((ext_vector_type(2)));
__device__ __forceinline__ unsigned cvt2(float lo, float hi) { f32x2 v = {lo, hi}; bf16x2_t b = __builtin_convertvector(v, bf16x2_t); return __builtin_bit_cast(unsigned, b); }
__device__ __forceinline__ unsigned off_b(unsigned row, unsigned ch) { return 256u * row + 16u * (ch ^ (((row & 3) << 2) | ((row >> 2) & 3))); }
__device__ __forceinline__ s16x4 tr_read(unsigned addr) { s16x4 r; asm volatile("ds_read_b64_tr_b16 %0, %1\n\ts_waitcnt lgkmcnt(0)" : "=&v"(r) : "v"(addr) : "memory"); return r; }
constexpr int QDS = 528, KTS = 144, QDS2 = 544;
constexpr int O_QD = 0, O_KD = 33792, O_KDT = 67584, O_V = 104448, O_ATT = 120832, O_TOT = 130048, O_EDEC = 134144;
}
constexpr size_t PREP_ITEM = 74752, PREP_KDT = 32768, PREP_ATT = 65536, PREP_EDEC = 73728;
constexpr size_t WS_PREP = WS_PART;
static_assert(WS_PREP + (size_t)NB * 4 * 2 * 68 * PREP_ITEM <= (size_t)1610612736, "prep tiles must fit below the guaranteed workspace size");
__device__ __forceinline__ void gla_prep(const Frame& F0, const Args& P) {
    using namespace gsc;
    const Frame F = relaunder(F0);
    const bf16* X = (const bf16*)(wsp(P) + WS_BIG);
    const int t = F.tid, w = F.wave, lane = F.lane, n16 = lane & 15, q4 = lane >> 4;
    LAS unsigned char* L = F.lds;
    const int dp = t & 127, rq = t >> 7, d0 = 2 * dp;
    constexpr int NIT = NB * 4 * 68 * 2;
    unsigned rQ[16], rK[16], rG[16];
#define GPR_LOAD(it_) do { const int dir_ = (it_) & 1, ci_ = ((it_) >> 1) % 68, hh_ = (((it_) >> 1) / 68) & 3, b_ = ((it_) >> 1) / 272; \
        const int r0_ = ci_ < 4 ? ML + b_ * CTXL + ci_ * 64 : b_ * SEQ + (ci_ - 4) * 64; const bf16* xp_ = X + (size_t)(r0_ + 16 * rq) * BIG_LD + hh_ * 256 + d0; \
        _Pragma("unroll") for (int r = 0; r < 16; ++r) { rQ[r] = *(const unsigned*)(xp_ + (size_t)r * BIG_LD); rK[r] = *(const unsigned*)(xp_ + (size_t)r * BIG_LD + 1024); rG[r] = *(const unsigned*)(xp_ + (size_t)r * BIG_LD + 6144 + dir_ * 1024); } } while (0)
    if (F.vb < NIT) GPR_LOAD(F.vb);
    for (int it = F.vb; it < NIT; it += F.G) {
        const int dir = it & 1, cidx = (it >> 1) % 68, hh = ((it >> 1) / 68) & 3, b = (it >> 1) / 272;
        float bb0[16], bb1[16]; float run0 = 0.f, run1 = 0.f;
        if (dir == 0) {
#pragma unroll
            for (int r = 0; r < 16; ++r) { run0 += bflo(rG[r]); run1 += bfhi(rG[r]); bb0[r] = run0; bb1[r] = run1; }
        } else {
#pragma unroll
            for (int r = 15; r >= 0; --r) { run0 += bflo(rG[r]); run1 += bfhi(rG[r]); bb0[r] = run0; bb1[r] = run1; }
        }
        *(LAS f32x2*)(L + O_TOT + (rq * 256 + d0) * 4) = (f32x2){run0, run1};
        __syncthreads();
        float off0 = 0.f, off1 = 0.f, bt0 = 0.f, bt1 = 0.f;
#pragma unroll
        for (int g = 0; g < 4; ++g) { const f32x2 tv = *(const LAS f32x2*)(L + O_TOT + (g * 256 + d0) * 4); bt0 += tv[0]; bt1 += tv[1];
            const bool inc = (dir == 0) ? (g < rq) : (g > rq); off0 += inc ? tv[0] : 0.f; off1 += inc ? tv[1] : 0.f; }
        const float ed0 = __expf(bt0), ed1 = __expf(bt1);
        if (rq == 0) *(LAS f32x2*)(L + O_EDEC + d0 * 4) = (f32x2){ed0, ed1};
        unsigned kt0[8], kt1[8];
#pragma unroll
        for (int r = 0; r < 16; r += 2) {
            float kd0[2], kd1[2];
#pragma unroll
            for (int u = 0; u < 2; ++u) { const float b0 = bb0[r + u] + off0, b1 = bb1[r + u] + off1;
                const float q0 = bflo(rQ[r + u]), q1 = bfhi(rQ[r + u]), k0 = bflo(rK[r + u]), k1 = bfhi(rK[r + u]);
                const float e0 = __expf(fmaxf(b0, -80.f)), e1 = __expf(fmaxf(b1, -80.f)), i0 = __builtin_amdgcn_rcpf(e0), i1 = __builtin_amdgcn_rcpf(e1);
                const float kk0 = k0 * i0, kk1 = k1 * i1;
                *(LAS unsigned*)(L + O_QD + (16 * rq + r + u) * QDS + d0 * 2) = cvt2(q0 * e0, q1 * e1);
                *(LAS unsigned*)(L + O_KD + (16 * rq + r + u) * QDS + d0 * 2) = cvt2(kk0, kk1);
                kd0[u] = kk0 * ed0; kd1[u] = kk1 * ed1; }
            kt0[r >> 1] = cvt2(kd0[0], kd0[1]); kt1[r >> 1] = cvt2(kd1[0], kd1[1]);
        }
        *(LAS v4u*)(L + O_KDT + d0 * KTS + rq * 32) = (v4u){kt0[0], kt0[1], kt0[2], kt0[3]}; *(LAS v4u*)(L + O_KDT + d0 * KTS + rq * 32 + 16) = (v4u){kt0[4], kt0[5], kt0[6], kt0[7]};
        *(LAS v4u*)(L + O_KDT + (d0 + 1) * KTS + rq * 32) = (v4u){kt1[0], kt1[1], kt1[2], kt1[3]}; *(LAS v4u*)(L + O_KDT + (d0 + 1) * KTS + rq * 32 + 16) = (v4u){kt1[4], kt1[5], kt1[6], kt1[7]};
        if (it + F.G < NIT) GPR_LOAD(it + F.G);
        __syncthreads();
        { const int ib = w >> 1, jb0 = (w & 1) * 2; f32x4 a0 = (f32x4){0.f, 0.f, 0.f, 0.f}, a1 = a0;
#pragma unroll
          for (int ks = 0; ks < 8; ++ks) { const int co = (32 * ks + 8 * q4) * 2;
              const bf16x8 af = *(const LAS bf16x8*)(L + O_QD + (16 * ib + n16) * QDS + co);
              const bf16x8 b0 = *(const LAS bf16x8*)(L + O_KD + (16 * jb0 + n16) * QDS + co), b1 = *(const LAS bf16x8*)(L + O_KD + (16 * jb0 + 16 + n16) * QDS + co);
              a0 = __builtin_amdgcn_mfma_f32_16x16x32_bf16(af, b0, a0, 0, 0, 0); a1 = __builtin_amdgcn_mfma_f32_16x16x32_bf16(af, b1, a1, 0, 0, 0); }
#pragma unroll
          for (int r = 0; r < 4; ++r) { const int i = 16 * ib + 4 * q4 + r, j0 = 16 * jb0 + n16, j1 = j0 + 16;
              const bool k0 = (dir == 0) ? (j0 <= i) : (j0 >= i), k1 = (dir == 0) ? (j1 <= i) : (j1 >= i);
              *(LAS bf16*)(L + O_ATT + i * KTS + j0 * 2) = (bf16)f2bf(k0 ? a0[r] : 0.f); *(LAS bf16*)(L + O_ATT + i * KTS + j1 * 2) = (bf16)f2bf(k1 ? a1[r] : 0.f); }
        }
        __syncthreads();
        unsigned char* G = (unsigned char*)wsp(P) + WS_PREP + ((size_t)((b * 4 + hh) * 2 + dir) * 68 + cidx) * PREP_ITEM;
#pragma unroll
        for (int i = 0; i < 4; ++i) { const int idx = t + 512 * i, row = idx >> 5, ch = idx & 31;
            const LAS unsigned char* sp = L + O_QD + row * QDS + (32 * (ch >> 2) + 4 * (ch & 3)) * 2;
            const v2u lo = *(const LAS v2u*)sp, hi = *(const LAS v2u*)(sp + 32); *(v4u*)(G + row * 512 + ch * 16) = (v4u){lo.x, lo.y, hi.x, hi.y}; }
#pragma unroll
        for (int i = 0; i < 4; ++i) { const int idx = t + 512 * i, row = idx >> 3, ch = idx & 7; *(v4u*)(G + PREP_KDT + row * 128 + ch * 16) = *(const LAS v4u*)(L + O_KDT + row * KTS + ch * 16); }
        { const int row = t >> 3, ch = t & 7; *(v4u*)(G + PREP_ATT + row * 128 + ch * 16) = *(const LAS v4u*)(L + O_ATT + row * KTS + ch * 16); }
        if (t < 64) *(v4u*)(G + PREP_EDEC + t * 16) = *(const LAS v4u*)(L + O_EDEC + t * 16);
    }
#undef GPR_LOAD
}
__device__ __forceinline__ void gla_scan2(const Frame& F0, const Args& P) {
    using namespace gsc;
    const Frame F = relaunder(F0);
    const bf16* X = (const bf16*)(wsp(P) + WS_BIG);
    const int t = F.tid, w = F.wave, lane = F.lane, n16 = lane & 15, q4 = lane >> 4;
    LAS unsigned char* L = F.lds;
    const int vr = t >> 3, vc = (t & 7) * 2;
    for (int it = F.vb; it < 256; it += F.G) {
        const int sl = it & 3, dir = (it >> 2) & 1, hh = (it >> 3) & 3, b = it >> 5;
        bf16* O = (bf16*)(wsp(P) + (dir == 0 ? WS_R1 : WS_R2));
        const unsigned char* GB = (const unsigned char*)wsp(P) + WS_PREP + (size_t)((b * 4 + hh) * 2 + dir) * 68 * PREP_ITEM;
        f32x4 S[16];
#pragma unroll
        for (int i = 0; i < 16; ++i) S[i] = (f32x4){0.f, 0.f, 0.f, 0.f};
        v4u rq_[4], rk_[4], ra_, re_, rV0, rV1;
#define GS2_ROW0(s_) ((s_) < 4 ? ML + b * CTXL + (dir == 0 ? (s_) : 3 - (s_)) * 64 : b * SEQ + (dir == 0 ? (s_) - 4 : 67 - (s_)) * 64)
#define GS2_CIDX(s_) (dir == 0 ? (s_) : ((s_) < 4 ? 3 - (s_) : 71 - (s_)))
#define GS2_LOAD(s_) do { const unsigned char* g_ = GB + (size_t)GS2_CIDX(s_) * PREP_ITEM; \
        _Pragma("unroll") for (int i = 0; i < 4; ++i) { const int idx = t + 512 * i; rq_[i] = *(const v4u*)(g_ + (idx >> 5) * 512 + (idx & 31) * 16); rk_[i] = *(const v4u*)(g_ + PREP_KDT + (idx >> 3) * 128 + (idx & 7) * 16); } \
        ra_ = *(const v4u*)(g_ + PREP_ATT + (t >> 3) * 128 + (t & 7) * 16); re_ = *(const v4u*)(g_ + PREP_EDEC + (t & 63) * 16); \
        const v4u* vp_ = (const v4u*)(X + (size_t)(GS2_ROW0(s_) + vr) * BIG_LD + 2048 + hh * 512 + sl * 128 + vc * 8); rV0 = vp_[0]; rV1 = vp_[1]; } while (0)
        GS2_LOAD(0);
        for (int s = 0; s < 68; ++s) {
            const int row0 = GS2_ROW0(s);
            __syncthreads();
#pragma unroll
            for (int i = 0; i < 4; ++i) { const int idx = t + 512 * i; *(LAS v4u*)(L + O_QD + (idx >> 5) * QDS2 + (idx & 31) * 16) = rq_[i]; *(LAS v4u*)(L + O_KDT + (idx >> 3) * KTS + (idx & 7) * 16) = rk_[i]; }
            *(LAS v4u*)(L + O_ATT + (t >> 3) * KTS + (t & 7) * 16) = ra_;
            if (t < 64) *(LAS v4u*)(L + O_EDEC + t * 16) = re_;
            *(LAS v4u*)(L + O_V + off_b(vr, vc)) = rV0; *(LAS v4u*)(L + O_V + off_b(vr, vc + 1)) = rV1;
            if (s + 1 < 68) GS2_LOAD(s + 1);
            __syncthreads();
#define GS2_SB() __builtin_amdgcn_sched_barrier(0)
            bf16x8 vf[2];
            { const unsigned qq = (lane & 15) >> 2, pp = lane & 3, vb_ = (unsigned)(uintptr_t)(L + O_V) + 8 * (pp & 1);
              s16x4 t0, t1, t2, t3;
              asm volatile("ds_read_b64_tr_b16 %0, %4\n\tds_read_b64_tr_b16 %1, %5\n\tds_read_b64_tr_b16 %2, %6\n\tds_read_b64_tr_b16 %3, %7\n\ts_waitcnt lgkmcnt(0)"
                           : "=&v"(t0), "=&v"(t1), "=&v"(t2), "=&v"(t3)
                           : "v"(vb_ + off_b(8 * q4 + qq, 2 * w + (pp >> 1))), "v"(vb_ + off_b(8 * q4 + 4 + qq, 2 * w + (pp >> 1))),
                             "v"(vb_ + off_b(32 + 8 * q4 + qq, 2 * w + (pp >> 1))), "v"(vb_ + off_b(32 + 8 * q4 + 4 + qq, 2 * w + (pp >> 1))) : "memory");
              vf[0] = (bf16x8){t0[0], t0[1], t0[2], t0[3], t1[0], t1[1], t1[2], t1[3]}; vf[1] = (bf16x8){t2[0], t2[1], t2[2], t2[3], t3[0], t3[1], t3[2], t3[3]}; }
            f32x4 oa[4];
#pragma unroll
            for (int ib = 0; ib < 4; ++ib) oa[ib] = (f32x4){0.f, 0.f, 0.f, 0.f};
            bf16x8 aq[2][4];
#define GS2_LDQ(set, kb) do { _Pragma("unroll") for (int ib = 0; ib < 4; ++ib) aq[set][ib] = *(const LAS bf16x8*)(L + O_QD + (16 * ib + n16) * QDS2 + (32 * (kb) + 8 * q4) * 2); } while (0)
            bf16x8 at[2][4];
#define GS2_LDA(ks) do { _Pragma("unroll") for (int ib = 0; ib < 4; ++ib) at[ks][ib] = *(const LAS bf16x8*)(L + O_ATT + (16 * ib + n16) * KTS + (32 * (ks) + 8 * q4) * 2); } while (0)
            GS2_LDQ(0, 0); GS2_SB();
#pragma unroll
            for (int kb = 0; kb < 8; ++kb) {
                if (kb < 7) GS2_LDQ((kb + 1) & 1, kb + 1); else GS2_LDA(0);
                GS2_SB();
                const v4u sw = {cvt2(S[2 * kb][0], S[2 * kb][1]), cvt2(S[2 * kb][2], S[2 * kb][3]), cvt2(S[2 * kb + 1][0], S[2 * kb + 1][1]), cvt2(S[2 * kb + 1][2], S[2 * kb + 1][3])};
                const bf16x8 sb = __builtin_bit_cast(bf16x8, sw);
#pragma unroll
                for (int ib = 0; ib < 4; ++ib) oa[ib] = __builtin_amdgcn_mfma_f32_16x16x32_bf16(sb, aq[kb & 1][ib], oa[ib], 0, 0, 0);
                GS2_SB();
            }
            f32x4 ed[2]; bf16x8 kf[2][2];
#define GS2_LDD(set, db) do { ed[set] = *(const LAS f32x4*)(L + O_EDEC + (16 * (db) + 4 * q4) * 4); \
                kf[set][0] = *(const LAS bf16x8*)(L + O_KDT + (16 * (db) + n16) * KTS + (8 * q4) * 2); kf[set][1] = *(const LAS bf16x8*)(L + O_KDT + (16 * (db) + n16) * KTS + (32 + 8 * q4) * 2); } while (0)
            GS2_LDA(1); GS2_SB();
#pragma unroll
            for (int ib = 0; ib < 4; ++ib) oa[ib] = __builtin_amdgcn_mfma_f32_16x16x32_bf16(vf[0], at[0][ib], oa[ib], 0, 0, 0);
            GS2_SB(); GS2_LDD(0, 0); GS2_SB();
#pragma unroll
            for (int ib = 0; ib < 4; ++ib) oa[ib] = __builtin_amdgcn_mfma_f32_16x16x32_bf16(vf[1], at[1][ib], oa[ib], 0, 0, 0);
            GS2_SB();
#pragma unroll
            for (int ib = 0; ib < 4; ++ib) *(v2u*)(O + (size_t)(row0 + 16 * ib + n16) * D + hh * 512 + sl * 128 + 16 * w + 4 * q4) = (v2u){cvt2(oa[ib][0], oa[ib][1]), cvt2(oa[ib][2], oa[ib][3])};
#pragma unroll
            for (int db = 0; db < 16; ++db) {
                if (db < 15) GS2_LDD((db + 1) & 1, db + 1);
                GS2_SB();
                f32x4 acc = S[db] * ed[db & 1];
                acc = __builtin_amdgcn_mfma_f32_16x16x32_bf16(kf[db & 1][0], vf[0], acc, 0, 0, 0);
                acc = __builtin_amdgcn_mfma_f32_16x16x32_bf16(kf[db & 1][1], vf[1], acc, 0, 0, 0);
                S[db] = acc;
                GS2_SB();
            }
        }
#undef GS2_SB
#undef GS2_LDQ
#undef GS2_LDA
#undef GS2_LDD
#undef GS2_ROW0
#undef GS2_CIDX
#undef GS2_LOAD
    }
}

__device__ __forceinline__ void gla_post(const Frame& F0, const Args& P, int L) {
    const Frame F = relaunder(F0);
    const int gw = F.bid * NWAVES + F.wave, NGW = F.G * NWAVES; const int nrows = (L == DEPTH - 1) ? ML : MT; const int j = L / 3;
    const bf16* OF = (const bf16*)(wsp(P) + WS_R1); const bf16* OB = (const bf16*)(wsp(P) + WS_R2); bf16* X = (bf16*)(wsp(P) + WS_BIG);
    const float* gh = inp(P, I_GGH) + j * 512 + 8 * F.lane;
    float g[8];
#pragma unroll
    for (int i = 0; i < 8; ++i) g[i] = gh[i];
#define GP_LOAD(R, row) { _Pragma("unroll") for (int hh = 0; hh < 4; ++hh) { R[hh][0] = *(const v4u*)(OF + (size_t)(row) * D + hh * 512 + 8 * F.lane); R[hh][1] = *(const v4u*)(OB + (size_t)(row) * D + hh * 512 + 8 * F.lane); \
            R[hh][2] = *(const v4u*)(X + (size_t)(row) * BIG_LD + 4096 + hh * 512 + 8 * F.lane); } }
#define GP_BODY(R, row) { _Pragma("unroll") for (int hh = 0; hh < 4; ++hh) { const v4u a = R[hh][0], c = R[hh][1], rr = R[hh][2]; \
            float o[8] = {bflo(a.x) + bflo(c.x), bfhi(a.x) + bfhi(c.x), bflo(a.y) + bflo(c.y), bfhi(a.y) + bfhi(c.y), bflo(a.z) + bflo(c.z), bfhi(a.z) + bfhi(c.z), bflo(a.w) + bflo(c.w), bfhi(a.w) + bfhi(c.w)}; \
            const float rv[8] = {bflo(rr.x), bfhi(rr.x), bflo(rr.y), bfhi(rr.y), bflo(rr.z), bfhi(rr.z), bflo(rr.w), bfhi(rr.w)}; \
            float ss = 0.f; \
            _Pragma("unroll") for (int i = 0; i < 8; ++i) ss += o[i] * o[i]; \
            const float rstd = __builtin_amdgcn_rsqf(wave_sum(ss) * (1.0f / 512.0f) + EPS); \
            _Pragma("unroll") for (int i = 0; i < 8; ++i) o[i] = o[i] * rstd * g[i] * (rv[i] * __builtin_amdgcn_rcpf(1.0f + __expf(-rv[i]))); \
            v4u w; w.x = pk2(o[0], o[1]); w.y = pk2(o[2], o[3]); w.z = pk2(o[4], o[5]); w.w = pk2(o[6], o[7]); \
            *(v4u*)(X + (size_t)(row) * BIG_LD + hh * 512 + 8 * F.lane) = w; } }
    v4u ra[4][3], rb[4][3];
    int row = gw;
    if (row < nrows) GP_LOAD(ra, row);
    while (row < nrows) {
        const int r2 = row + NGW; if (r2 < nrows) GP_LOAD(rb, r2);
        GP_BODY(ra, row);
        if (r2 >= nrows) break;
        const int r3 = r2 + NGW; if (r3 < nrows) GP_LOAD(ra, r3);
        GP_BODY(rb, r2);
        row = r3;
    }
#undef GP_LOAD
#undef GP_BODY
}

struct MlaRow { v4u a0, a1; unsigned short x1, x2; float cs, sn; };
__device__ __forceinline__ void mla_norm(const Frame& F0, const Args& P) {
    const Frame F = relaunder(F0);
    const int gw = F.bid * NWAVES + F.wave, NGW = F.G * NWAVES;
    bf16* CB = (bf16*)(wsp(P) + WS_BIG); const float* rt = (const float*)(wsp(P) + WS_ROPE);
    const int f = F.lane & 31;
#define MN_LOAD(R, row) { const bf16* cr = CB + (size_t)(row) * MLA_CN; R.a0 = *(const v4u*)(cr + 8 * F.lane); R.a1 = *(const v4u*)(cr + 512 + 8 * F.lane); \
        if ((row) < ML) { const int tpos = (row) & (SEQ - 1); R.x1 = cr[1024 + f]; R.x2 = cr[1056 + f]; R.cs = rt[tpos * 32 + f]; R.sn = rt[SEQ * 32 + tpos * 32 + f]; } }
#define MN_PART(av, off) { const v4u a = av; float v[8] = {bflo(a.x), bfhi(a.x), bflo(a.y), bfhi(a.y), bflo(a.z), bfhi(a.z), bflo(a.w), bfhi(a.w)}; float ss = 0.f; \
        _Pragma("unroll") for (int i = 0; i < 8; ++i) ss += v[i] * v[i]; \
        const float rstd = __builtin_amdgcn_rsqf(wave_sum(ss) * (1.0f / 512.0f) + EPS); \
        v4u w; w.x = pk2(v[0] * rstd, v[1] * rstd); w.y = pk2(v[2] * rstd, v[3] * rstd); w.z = pk2(v[4] * rstd, v[5] * rstd); w.w = pk2(v[6] * rstd, v[7] * rstd); \
        *(v4u*)(cr + (off) + 8 * F.lane) = w; }
#define MN_BODY(R, row) { bf16* cr = CB + (size_t)(row) * MLA_CN; MN_PART(R.a0, 0) MN_PART(R.a1, 512) \
        if ((row) < ML) {                                       \
            const float x1 = bf2f(R.x1), x2 = bf2f(R.x2); const float o1 = x1 * R.cs - x2 * R.sn, o2 = x2 * R.cs + x1 * R.sn; \
            if (F.lane < 32) { cr[1024 + f] = (bf16)f2bf(o1); cr[1056 + f] = (bf16)f2bf(o2); } } }
    MlaRow ra, rb;
    int row = gw;
    if (row < MT) MN_LOAD(ra, row);
    while (row < MT) {
        const int r2 = row + NGW; if (r2 < MT) MN_LOAD(rb, r2);
        MN_BODY(ra, row);
        if (r2 >= MT) break;
        const int r3 = r2 + NGW; if (r3 < MT) MN_LOAD(ra, r3);
        MN_BODY(rb, r2);
        row = r3;
    }
#undef MN_LOAD
#undef MN_PART
#undef MN_BODY
}

__device__ __forceinline__ void swa_krope(const Frame& F0, const Args& P) {
    const Frame F = relaunder(F0);
    const int gw = F.bid * NWAVES + F.wave, NGW = F.G * NWAVES;
    bf16* X = (bf16*)(wsp(P) + WS_BIG); const float* rt = (const float*)(wsp(P) + WS_ROPE);
    for (int row = gw; row < ML; row += NGW) {
        const int tpos = row & (SEQ - 1); bf16* kr = X + (size_t)row * SWA_N + 2048;
#pragma unroll
        for (int i = 0; i < 2; ++i) { const int p = F.lane + 64 * i, hh = p >> 5, f = p & 31;
            const float x1 = bf2f(kr[hh * 64 + f]), x2 = bf2f(kr[hh * 64 + 32 + f]); const float cs = rt[tpos * 32 + f], sn = rt[SEQ * 32 + tpos * 32 + f];
            kr[hh * 64 + f] = (bf16)f2bf(x1 * cs - x2 * sn); kr[hh * 64 + 32 + f] = (bf16)f2bf(x2 * cs + x1 * sn); }
    }
}

namespace att {
typedef short bf16x8 __attribute__((ext_vector_type(8)));
typedef short s16x4 __attribute__((ext_vector_type(4)));
typedef float f32x16 __attribute__((ext_vector_type(16)));
typedef unsigned u32x4 __attribute__((ext_vector_type(4)));
#define ATT_SBAR() __builtin_amdgcn_sched_barrier(0)
__device__ __forceinline__ int crow(int r, int hi) { return (r & 3) + 8 * (r >> 2) + 4 * hi; }
__device__ __forceinline__ unsigned cvtpk(float lo, float hi) { unsigned r; asm volatile("v_cvt_pk_bf16_f32 %0, %1, %2" : "=v"(r) : "v"(lo), "v"(hi)); return r; }
template <int OFF> __device__ __forceinline__ s16x4 tr_read(int vb) { s16x4 r; asm volatile("ds_read_b64_tr_b16 %0, %1 offset:%2" : "=&v"(r) : "v"(vb), "i"(OFF) : "memory"); return r; }
__device__ __forceinline__ int v_rd_base(int lane) { return ((lane & 3) << 3) | (((lane >> 2) & 3) << 6) | (((lane >> 4) & 1) << 5) | (((lane >> 5) & 1) << 8); }

template <int KIND> struct Cfg;
template <> struct Cfg<0> { static constexpr int DQK = 192, DV = 128, NH = 16; static constexpr float SCALE = 0.07216878364870322f; };
template <> struct Cfg<1> { static constexpr int DQK = 64, DV = 64, NH = 32; static constexpr float SCALE = 0.125f; };

template <int KIND> struct Body {
    static constexpr int DQK = Cfg<KIND>::DQK, DV = Cfg<KIND>::DV, ND0 = DQK / 16, NCB = DV / 32, KROWB = DQK * 2;
    static constexpr int SHM_K = 64 * KROWB, SHM_V = 64 * DV * 2;
    static constexpr float SCALE = Cfg<KIND>::SCALE, THR = 8.f;
    static __device__ __forceinline__ int kswz(int row, int colB) { return row * KROWB + (colB ^ ((row & 7) << 4)); }
    static __device__ __forceinline__ int v_st(int k, int c) { const int kk = (k & ~0xC) | ((k & 4) << 1) | ((k & 8) >> 1); return ((kk >> 3) * NCB + (c >> 5)) * 512 + ((kk & 7) * 32 + (c & 31)) * 2; }
    static constexpr int v_rd_off(int d0, int ks, int half) { return d0 * 512 + ks * NCB * 1024 + half * NCB * 512; }

    static __device__ __forceinline__ void partialSM(f32x16& p0, f32x16& p1, float& m_reg, float& mn, float& alpha) {
        constexpr float C = SCALE * 1.4426950408889634f;
        float pmax = p0[0];
#pragma unroll
        for (int r = 1; r < 16; ++r) pmax = fmaxf(pmax, p0[r]);
#pragma unroll
        for (int r = 0; r < 16; ++r) pmax = fmaxf(pmax, p1[r]);
        { auto rr = __builtin_amdgcn_permlane32_swap(__float_as_uint(pmax), __float_as_uint(pmax), false, false); pmax = fmaxf(__uint_as_float(rr[0]), __uint_as_float(rr[1])); }
        if (__builtin_expect(__all(pmax - m_reg <= THR / SCALE), 1)) { mn = m_reg; alpha = 1.f; }
        else { mn = fmaxf(m_reg, pmax); alpha = __builtin_amdgcn_exp2f((m_reg - mn) * C); m_reg = mn; }
        const float mnC = -mn * C;
#pragma unroll
        for (int r = 0; r < 16; ++r) p0[r] = fmaf(p0[r], C, mnC);
#pragma unroll
        for (int r = 0; r < 16; ++r) p1[r] = fmaf(p1[r], C, mnC);
#pragma unroll
        for (int r = 0; r < 16; ++r) p0[r] = __builtin_amdgcn_exp2f(p0[r]);
    }
    static __device__ __forceinline__ void finishSM(f32x16& p0, f32x16& p1, float alpha, float& l_reg, bf16x8& pa0, bf16x8& pa1, bf16x8& pa2, bf16x8& pa3) {
#pragma unroll
        for (int r = 0; r < 16; ++r) p1[r] = __builtin_amdgcn_exp2f(p1[r]);
        float ps = 0;
#pragma unroll
        for (int r = 0; r < 16; ++r) ps += p0[r];
#pragma unroll
        for (int r = 0; r < 16; ++r) ps += p1[r];
        { auto rr = __builtin_amdgcn_permlane32_swap(__float_as_uint(ps), __float_as_uint(ps), false, false); ps = __uint_as_float(rr[0]) + __uint_as_float(rr[1]); }
        l_reg = l_reg * alpha + ps;
#define ATT_PK4(P, BASE, OUT) do { unsigned a0 = cvtpk(P[BASE + 0], P[BASE + 1]), a1 = cvtpk(P[BASE + 2], P[BASE + 3]);   \
    unsigned b0 = cvtpk(P[BASE + 4], P[BASE + 5]), b1 = cvtpk(P[BASE + 6], P[BASE + 7]);                              \
    auto r0 = __builtin_amdgcn_permlane32_swap(a0, b0, false, false); auto r1 = __builtin_amdgcn_permlane32_swap(a1, b1, false, false); \
    u32x4 w = {r0[0], r1[0], r0[1], r1[1]}; OUT = __builtin_bit_cast(bf16x8, w); } while (0)
        ATT_PK4(p0, 0, pa0); ATT_PK4(p0, 8, pa1); ATT_PK4(p1, 0, pa2); ATT_PK4(p1, 8, pa3);
#undef ATT_PK4
    }
    static __device__ __forceinline__ void kbases(int (&kb)[4], int r32, int hi) {
#pragma unroll
        for (int i = 0; i < 4; ++i) { kb[i] = kswz(r32, i * 32 + hi * 16); asm volatile("" : "+v"(kb[i])); } }
    static __device__ __forceinline__ void qkt(f32x16& p0, f32x16& p1, const LAS char* Ks, const bf16x8 (&qr)[ND0], const int (&kb)[4]) {
        p0 = f32x16{}; p1 = f32x16{};
#pragma unroll
        for (int d0 = 0; d0 < ND0; ++d0) { const LAS char* kp = Ks + kb[d0 & 3] + (d0 >> 2) * 128;
            const bf16x8 b0 = *(const LAS bf16x8*)kp;
            const bf16x8 b1 = *(const LAS bf16x8*)(kp + 32 * KROWB);
            p0 = __builtin_amdgcn_mfma_f32_32x32x16_bf16(b0, qr[d0], p0, 0, 0, 0);
            p1 = __builtin_amdgcn_mfma_f32_32x32x16_bf16(b1, qr[d0], p1, 0, 0, 0); }
    }
    template <int D0> static __device__ __forceinline__ void pv_one(f32x16& od, int vb, bf16x8 pa0, bf16x8 pa1, bf16x8 pa2, bf16x8 pa3) {
        const s16x4 l0 = tr_read<v_rd_off(D0, 0, 0)>(vb), h0 = tr_read<v_rd_off(D0, 0, 1)>(vb), l1 = tr_read<v_rd_off(D0, 1, 0)>(vb), h1 = tr_read<v_rd_off(D0, 1, 1)>(vb);
        const s16x4 l2 = tr_read<v_rd_off(D0, 2, 0)>(vb), h2 = tr_read<v_rd_off(D0, 2, 1)>(vb), l3 = tr_read<v_rd_off(D0, 3, 0)>(vb), h3 = tr_read<v_rd_off(D0, 3, 1)>(vb);
        asm volatile("s_waitcnt lgkmcnt(0)" ::: "memory"); ATT_SBAR();
#define ATT_PK(L, H) (bf16x8){L[0], L[1], L[2], L[3], H[0], H[1], H[2], H[3]}
        od = __builtin_amdgcn_mfma_f32_32x32x16_bf16(pa0, ATT_PK(l0, h0), od, 0, 0, 0);
        od = __builtin_amdgcn_mfma_f32_32x32x16_bf16(pa1, ATT_PK(l1, h1), od, 0, 0, 0);
        od = __builtin_amdgcn_mfma_f32_32x32x16_bf16(pa2, ATT_PK(l2, h2), od, 0, 0, 0);
        od = __builtin_amdgcn_mfma_f32_32x32x16_bf16(pa3, ATT_PK(l3, h3), od, 0, 0, 0);
#undef ATT_PK
    }
    static __device__ __forceinline__ void pv_all(f32x16 (&o)[NCB], int vb, bf16x8 pa0, bf16x8 pa1, bf16x8 pa2, bf16x8 pa3) {
        pv_one<0>(o[0], vb, pa0, pa1, pa2, pa3); pv_one<1>(o[1], vb, pa0, pa1, pa2, pa3);
        if constexpr (NCB == 4) { pv_one<2>(o[2], vb, pa0, pa1, pa2, pa3); pv_one<3>(o[3], vb, pa0, pa1, pa2, pa3); }
    }
};
}

template <int KIND>
__device__ __forceinline__ void attn_mfma(const Frame& F0, const Args& P, bool with_ctx) {
    using B = att::Body<KIND>; using att::bf16x8; using att::f32x16; using att::crow;
    constexpr int DQK = B::DQK, DV = B::DV, ND0 = B::ND0, NCB = B::NCB, NH = att::Cfg<KIND>::NH, SHM_K = B::SHM_K, SHM_V = B::SHM_V;
    const Frame F = relaunder(F0);
    const int tid = F.tid, wid = F.wave, lane = F.lane, r32 = lane & 31, hi = lane >> 5;
#define ATT_OPQ_(x) ({ int v_ = (x); asm volatile("" : "+v"(v_)); v_; })
    constexpr int NST = 3;
    const LAS char* V_lds = (const LAS char*)F.lds; const LAS char* K_lds = (const LAS char*)(F.lds + NST * SHM_V);
    LAS float* wsf = (LAS float*)(F.lds + NST * (SHM_V + SHM_K)) + wid * 64; LAS float* li_l = wsf; LAS float* al_l = wsf + 32;
    static_assert(NST * (SHM_V + SHM_K) + NWAVES * 256 <= LDSCTL_OFF, "attention LDS");
    constexpr int NKB = SHM_K / 8192, NVB = SHM_V / 8192;
    unsigned koff[NKB], voff[NVB];
    { const int l_ = ATT_OPQ_(lane);
#pragma unroll
      for (int i = 0; i < NKB; ++i) { const int p = (wid + 8 * i) * 1024 + 16 * l_; const int row = p / B::KROWB, within = p % B::KROWB, colB = within ^ ((row & 7) << 4);
          if (KIND == 0) koff[i] = colB < 256 ? (unsigned)(row * (MLA_KVN * 2) + colB) : (0x80000000u | (unsigned)(row * (MLA_CN * 2) + (colB - 256)));
          else koff[i] = (unsigned)(row * (SWA_N * 2) + colB); }
#pragma unroll
      for (int i = 0; i < NVB; ++i) { const int p = (wid + 8 * i) * 1024 + 16 * l_; const int blk = p >> 9, r = p & 511; const int kk = (blk / NCB) * 8 + (r >> 6), c = (blk % NCB) * 32 + ((r & 63) >> 1);
          const int k = (kk & ~0xC) | ((kk & 4) << 1) | ((kk & 8) >> 1);
          voff[i] = KIND == 0 ? (unsigned)(k * (MLA_KVN * 2) + (128 + c) * 2) : (unsigned)(k * (SWA_N * 2) + (256 + c) * 2); } }
    const bf16* BIG = (const bf16*)(wsp(P) + WS_BIG); const float* rt = (const float*)(wsp(P) + WS_ROPE);
    const bf16* CB = BIG; const bf16* QB = BIG + (size_t)MT * MLA_CN; const bf16* KVB = QB + (size_t)MT * MLA_QN;
    bf16* O = (bf16*)(wsp(P) + WS_R1);
#define ATT_OPQ(x) ({ int v_ = (x); asm volatile("" : "+v"(v_)); v_; })
#define ATT_VB(bb) ((int)(uintptr_t)V_lds + (bb) * SHM_V + att::v_rd_base(ATT_OPQ(lane)))
    const int n_lat = KIND == 0 ? NB * NH * 16 : NB * 4 * 32 * 4, n_ctx = with_ctx ? (KIND == 0 ? NB * NH : NB * 4 * 8) : 0;
    for (int u = F.vb; u < n_lat + n_ctx; u += F.G) {
        const bool isctx = u >= n_lat; const int uu = isctx ? u - n_lat : u;
        int b, head, kvh, qrow, tq = 0, nblk = 0, NT;
        if (KIND == 0) {
            if (!isctx) { const int qb = uu & 15; head = (uu >> 4) & 15; b = uu >> 8; tq = qb * 256 + wid * 32 + r32; qrow = b * SEQ + tq; NT = 68; }
            else { head = uu & 15; b = uu >> 4; qrow = ML + b * CTXL + wid * 32 + r32; NT = 4; }
            kvh = head;
        } else {
            if (!isctx) { const int sub = uu & 3; nblk = (uu >> 2) & 31; kvh = (uu >> 7) & 3; b = uu >> 9; head = kvh * 8 + sub * 2 + (wid >> 2); tq = nblk * 128 + (wid & 3) * 32 + r32; qrow = b * SEQ + tq;
                NT = 10 - ((nblk == 0 || nblk == 31) ? 2 : 0); }
            else { const int sub = uu & 7; kvh = (uu >> 3) & 3; b = uu >> 5; head = kvh * 8 + sub; qrow = ML + b * CTXL + wid * 32 + r32; NT = 4; }
        }
        const int wt0 = (KIND == 1 && !isctx && nblk == 0) ? 2 : 0;
#define ATT_KROW(kt) ((kt) < 4 ? ML + b * CTXL + (kt) * 64 : (KIND == 0 ? b * SEQ + ((kt) - 4) * 64 : b * SEQ + (nblk - 1) * 128 + ((kt) - 4 + wt0) * 64))
#define ATT_DMA(kt, st) do { const int kr_ = ATT_KROW(kt); \
        if (KIND == 0) { const char* kvb_ = (const char*)(KVB + (size_t)kr_ * MLA_KVN + kvh * 256); const char* cbb_ = (const char*)(CB + (size_t)kr_ * MLA_CN + 1024); \
            _Pragma("unroll") for (int i = 0; i < NKB; ++i) { const unsigned o_ = koff[i]; const char* src_ = (o_ >> 31) ? cbb_ + (o_ & 0x7fffffffu) : kvb_ + o_; \
                __builtin_amdgcn_global_load_lds((const unsigned*)src_, (LAS unsigned*)(F.lds + NST * SHM_V + (st) * SHM_K + (wid + 8 * i) * 1024), 16, 0, 0); } \
            _Pragma("unroll") for (int i = 0; i < NVB; ++i) __builtin_amdgcn_global_load_lds((const unsigned*)(kvb_ + voff[i]), (LAS unsigned*)(F.lds + (st) * SHM_V + (wid + 8 * i) * 1024), 16, 0, 0); } \
        else { const char* kb_ = (const char*)(BIG + (size_t)kr_ * SWA_N + 2048 + kvh * 64); \
            __builtin_amdgcn_global_load_lds((const unsigned*)(kb_ + koff[0]), (LAS unsigned*)(F.lds + NST * SHM_V + (st) * SHM_K + wid * 1024), 16, 0, 0); \
            __builtin_amdgcn_global_load_lds((const unsigned*)(kb_ + voff[0]), (LAS unsigned*)(F.lds + (st) * SHM_V + wid * 1024), 16, 0, 0); } } while (0)
        __syncthreads();
        ATT_DMA(0, 0); ATT_DMA(1, 1);
        bf16x8 qr[ND0];
        { const bf16* Qw = (KIND == 0 ? QB + (size_t)qrow * MLA_QN + head * 192 : BIG + (size_t)qrow * SWA_N + head * 64) + hi * 8;
#pragma unroll
          for (int d0 = 0; d0 < ND0; ++d0) qr[d0] = *(const bf16x8*)(Qw + d0 * 16);
          if (!isctx) { constexpr int RB = KIND == 0 ? 8 : 0;
#pragma unroll
            for (int i = 0; i < 2; ++i) { const float* cp = rt + ATT_OPQ(tq * 32 + hi * 8) + i * 16; const float* sp = cp + SEQ * 32;
                const f32x4 c0 = *(const f32x4*)cp, c1 = *(const f32x4*)(cp + 4), s0 = *(const f32x4*)sp, s1 = *(const f32x4*)(sp + 4);
                const float cs[8] = {c0[0], c0[1], c0[2], c0[3], c1[0], c1[1], c1[2], c1[3]}, sn[8] = {s0[0], s0[1], s0[2], s0[3], s1[0], s1[1], s1[2], s1[3]};
                float y1[8], y2[8];
#pragma unroll
                for (int j = 0; j < 8; ++j) { const float x1 = bf2f((bf16)qr[RB + i][j]), x2 = bf2f((bf16)qr[RB + 2 + i][j]); y1[j] = x1 * cs[j] - x2 * sn[j]; y2[j] = x2 * cs[j] + x1 * sn[j]; }
                att::u32x4 w1 = {att::cvtpk(y1[0], y1[1]), att::cvtpk(y1[2], y1[3]), att::cvtpk(y1[4], y1[5]), att::cvtpk(y1[6], y1[7])};
                att::u32x4 w2 = {att::cvtpk(y2[0], y2[1]), att::cvtpk(y2[2], y2[3]), att::cvtpk(y2[4], y2[5]), att::cvtpk(y2[6], y2[7])};
                qr[RB + i] = __builtin_bit_cast(bf16x8, w1); qr[RB + 2 + i] = __builtin_bit_cast(bf16x8, w2); } }
        }
        int kb[4]; B::kbases(kb, r32, hi);
        float m_reg = -1e30f, l_reg = 0.f;
        if (KIND == 1) { m_reg = inp(P, I_SSINK)[head] * (1.0f / B::SCALE); l_reg = 1.0f; }
        f32x16 o[NCB];
#pragma unroll
        for (int d = 0; d < NCB; ++d) o[d] = f32x16{};
#define ATT_VMW() asm volatile("s_waitcnt vmcnt(0)" ::: "memory")
#define ATT_RESC(a) do { if (__any((a) < 1.f)) { if (hi == 0) al_l[r32] = (a); asm volatile("s_waitcnt lgkmcnt(0)" ::: "memory"); \
        _Pragma("unroll") for (int d = 0; d < NCB; ++d) _Pragma("unroll") for (int r = 0; r < 16; ++r) o[d][r] *= al_l[crow(r, hi)]; } } while (0)
#define ATT_MASK(p0, p1, kt) do { if (KIND == 1 && !isctx && (kt) >= 4) { const int k0_ = (nblk - 1) * 128 + ((kt) - 4 + wt0) * 64, dq = tq - k0_; const int dw_ = __builtin_amdgcn_readfirstlane(tq - r32) - k0_; \
        if (dw_ + 31 > 128 || dw_ - 63 < -128)     \
        _Pragma("unroll") for (int r = 0; r < 16; ++r) { const int d0_ = dq - crow(r, hi), d1_ = d0_ - 32; \
            if (d0_ > 128 || d0_ < -128) p0[r] = -INFINITY; if (d1_ > 128 || d1_ < -128) p1[r] = -INFINITY; } } } while (0)
        f32x16 pA0, pA1, pB0, pB1; float mnA, mnB, alA, alB; bf16x8 pa0, pa1, pa2, pa3;
#define ATT_NX(s_) ((s_) == NST - 1 ? 0 : (s_) + 1)
#define ATT_PV_(s_) ((s_) == 0 ? NST - 1 : (s_) - 1)
        ATT_VMW(); __syncthreads();
        B::qkt(pA0, pA1, K_lds, qr, kb); ATT_MASK(pA0, pA1, 0); B::partialSM(pA0, pA1, m_reg, mnA, alA);
        int sj = 1;
        for (int j = 1; j + 1 < NT; j += 2) {
            { const int sn = ATT_NX(sj); ATT_DMA(j + 1, sn); }
            ATT_SBAR(); B::qkt(pB0, pB1, K_lds + sj * SHM_K, qr, kb); ATT_MASK(pB0, pB1, j);
            B::finishSM(pA0, pA1, alA, l_reg, pa0, pa1, pa2, pa3); ATT_SBAR();
            B::pv_all(o, ATT_VB(ATT_PV_(sj)), pa0, pa1, pa2, pa3); B::partialSM(pB0, pB1, m_reg, mnB, alB);
            ATT_RESC(alB); ATT_VMW(); __syncthreads();
            sj = ATT_NX(sj);
            if (j + 2 < NT) { const int sn = ATT_NX(sj); ATT_DMA(j + 2, sn); }
            ATT_SBAR(); B::qkt(pA0, pA1, K_lds + sj * SHM_K, qr, kb); ATT_MASK(pA0, pA1, j + 1);
            B::finishSM(pB0, pB1, alB, l_reg, pa0, pa1, pa2, pa3); ATT_SBAR();
            B::pv_all(o, ATT_VB(ATT_PV_(sj)), pa0, pa1, pa2, pa3); B::partialSM(pA0, pA1, m_reg, mnA, alA);
            ATT_RESC(alA); ATT_VMW(); __syncthreads();
            sj = ATT_NX(sj);
        }
        ATT_SBAR(); B::qkt(pB0, pB1, K_lds + sj * SHM_K, qr, kb); ATT_MASK(pB0, pB1, NT - 1);
        B::finishSM(pA0, pA1, alA, l_reg, pa0, pa1, pa2, pa3); ATT_SBAR();
        B::pv_all(o, ATT_VB(ATT_PV_(sj)), pa0, pa1, pa2, pa3); B::partialSM(pB0, pB1, m_reg, mnB, alB);
        ATT_RESC(alB);
        B::finishSM(pB0, pB1, alB, l_reg, pa0, pa1, pa2, pa3); ATT_SBAR();
        B::pv_all(o, ATT_VB(sj), pa0, pa1, pa2, pa3);
#undef ATT_NX
#undef ATT_PV_
        if (hi == 0) li_l[r32] = l_reg; asm volatile("s_waitcnt lgkmcnt(0)" ::: "memory");
        const int qrow_w = qrow - r32;
#pragma unroll
        for (int r = 0; r < 16; ++r) { const int orow = crow(r, hi); const float rl = __builtin_amdgcn_rcpf(li_l[orow]);
            bf16* op = O + (size_t)(qrow_w + orow) * D + head * DV + r32;
#pragma unroll
            for (int d0 = 0; d0 < NCB; ++d0) op[d0 * 32] = (bf16)f2bf(o[d0][r] * rl); }
#undef ATT_KROW
#undef ATT_OPQ
#undef ATT_OPQ_
#undef ATT_VB
#undef ATT_DMA
#undef ATT_VMW
#undef ATT_RESC
#undef ATT_MASK
    }
}

constexpr int PH_PRO = 0, PH_PRE0 = 1, PH_L0 = 2, PH_PER_LAYER = 10, N_PHASES = PH_L0 + DEPTH * PH_PER_LAYER;
__host__ __device__ inline bool phase_exists(int p) {
    if (p < PH_L0) return true;
    const int L = (p - PH_L0) / PH_PER_LAYER, slot = (p - PH_L0) % PH_PER_LAYER, kind = L % 3;
    if (slot == 3) return kind != 2;
    if (slot == 4) return kind == 0;
    return true;
}

__global__ void __launch_bounds__(NTHREADS, 2) mk_fwd(Args args) {
    extern __shared__ __attribute__((aligned(16))) unsigned char lds[];
    Frame F;
    F.lds = (LAS unsigned char*)lds;
    F.tid = threadIdx.x; F.lane = F.tid & 63; F.wave = __builtin_amdgcn_readfirstlane(F.tid >> 6); F.G = gridDim.x; F.bid = blockIdx.x;
    const Args& P = args;
    for (int u = F.tid; u < (LDS_BYTES - LDSCTL_OFF) / 4; u += NTHREADS) ((LAS unsigned*)(F.lds + LDSCTL_OFF))[u] = 0u;
    __syncthreads();
    const int lo = args.ph_lo, hi = args.ph_hi;
    XcdBarrier bar; bar.bar = (unsigned*)(wsp(P) + WS_CTL) + CW_BAR; bar.x = 0; bar.st = nullptr;
    if (hi - lo > 1) bar = xcd_barrier_post((unsigned*)(wsp(P) + WS_CTL) + CW_BAR, (volatile LAS unsigned*)(F.lds + LDSCTL_OFF + 32), F.tid == 0);
#define IN(k) (lo <= (k) && (k) < hi)
#define SEAM(k) do { if ((k) + 1 < hi) for (int xr_ = 0; xr_ < ((REP_MASK & 256) ? 5 : 1); ++xr_) { XcdBarrier bb_ = bar; bb_.bar = (unsigned*)(wsp(P) + WS_CTL) + CW_BAR; xcd_barrier(bb_, hw_tid(F.wave) == 0); } } while (0)
    using pg8::EpiPlain; using pg8::EpiSwiGlu; using pg8::bf16_t;
#define R1 ((bf16_t*)(wsp(P) + WS_R1))
#define R2 ((bf16_t*)(wsp(P) + WS_R2))
#define BIG ((bf16_t*)(wsp(P) + WS_BIG))

    if (IN(PH_PRO)) { for (int rep = 0; rep < REPN(1); ++rep) prologue(F, P); SEAM(PH_PRO); }
    if (IN(PH_PRE0)) { row_pass(F, P, 0, 0); SEAM(PH_PRE0); }
    for (int L = 0; L < DEPTH; ++L) {
        const int base = PH_L0 + L * PH_PER_LAYER, kind = L % 3; const bool last = (L == DEPTH - 1);
        const int Mout = last ? ML : MT;
        if (IN(base + 0)) { for (int rep = 0; rep < REPN(2); ++rep) {
            if (kind == 0) { pg8::EpiGlaIn E{BIG, BIG_LD, (float*)(wsp(P) + WS_GU)};
                pg8::gemm_phase<GLA_N, D, D, D, false, true>(F.lds, R1, (const bf16_t*)(wsp(P) + WS_WGI + (L / 3) * SZ_WGI), MT, F.G, F.bid, E, F.wave); }
            else if (kind == 1) { EpiPlain E{BIG, MLA_CN, nullptr, 0, 0}; pg8::gemm_phase<MLA_CN, D, D, D>(F.lds, R1, (const bf16_t*)(wsp(P) + WS_WMI), MT, F.G, F.bid, E, F.wave); }
            else { EpiPlain E{BIG, SWA_N, nullptr, 0, 0}; pg8::gemm_phase<SWA_N, D, D, D, false, true>(F.lds, R1, (const bf16_t*)(wsp(P) + WS_WSI), MT, F.G, F.bid, E, F.wave); } }
            SEAM(base + 0);
        }
        if (IN(base + 1)) {
            if (kind == 0) gla_gate(F, P, L); else if (kind == 1) mla_norm(F, P); else swa_krope(F, P);
            SEAM(base + 1);
        }
        if (IN(base + 2)) {
            if (kind == 0) gla_prep(F, P);
            else if (kind == 1) { for (int rep = 0; rep < REPN(2); ++rep) {
                { EpiPlain E{BIG + (size_t)MT * MLA_CN, MLA_QN, nullptr, 0, 0}; pg8::gemm_phase<MLA_QN, 512, MLA_CN, 512, false, true>(F.lds, BIG, (const bf16_t*)(wsp(P) + WS_WMUQ), MT, F.G, F.bid, E, F.wave); }
                { EpiPlain E{BIG + (size_t)MT * (MLA_CN + MLA_QN), MLA_KVN, nullptr, 0, 0}; pg8::gemm_phase<MLA_KVN, 512, MLA_CN, 512, false, true>(F.lds, BIG + 512, (const bf16_t*)(wsp(P) + WS_WMUKV), MT, F.G, F.bid, E, F.wave); }
            } }
            else { for (int rep = 0; rep < REPN(8); ++rep) attn_mfma<1>(F, P, !last); }
            SEAM(base + 2);
        }
        if (IN(base + 3) && kind != 2) {
            if (kind == 0) { for (int rep = 0; rep < REPN(4); ++rep) gla_scan2(F, P); }
            else { for (int rep = 0; rep < REPN(16); ++rep) attn_mfma<0>(F, P, !last); }
            SEAM(base + 3);
        }
        if (IN(base + 4) && kind == 0) { gla_post(F, P, L); SEAM(base + 4); }
        if (IN(base + 5)) { for (int rep = 0; rep < REPN(2); ++rep) {
            EpiPlain E{R2, D, (float*)(wsp(P) + WS_PART), ML, MC};
            if (kind == 0) pg8::gemm_phase<D, D, BIG_LD, D, true>(F.lds, BIG, (const bf16_t*)(wsp(P) + WS_WGO + (L / 3) * SZ_WDD), ML, F.G, F.bid, E, F.wave, Mout - ML);
            else pg8::gemm_phase<D, D, D, D, true>(F.lds, R1, (const bf16_t*)(wsp(P) + (kind == 1 ? WS_WMO : WS_WSO)), ML, F.G, F.bid, E, F.wave, Mout - ML); }
            SEAM(base + 5);
        }
        if (IN(base + 6)) { row_pass(F, P, L, 1); SEAM(base + 6); }
        if (IN(base + 7)) { for (int rep = 0; rep < REPN(32); ++rep) {
            EpiSwiGlu E{BIG, DFF}; pg8::gemm_phase<2 * DFF, D, D, D, false, true>(F.lds, R1, (const bf16_t*)(wsp(P) + WS_WFFI + L * SZ_WFFI), Mout, F.G, F.bid, E, F.wave); }
            SEAM(base + 7);
        }
        if (IN(base + 8)) { for (int rep = 0; rep < REPN(64); ++rep) {
            EpiPlain E{R1, D, (float*)(wsp(P) + WS_PART), ML, MC}; pg8::gemm_phase<D, DFF, DFF, DFF, true>(F.lds, BIG, (const bf16_t*)(wsp(P) + WS_WFFO + L * SZ_WFFO), ML, F.G, F.bid, E, F.wave, Mout - ML); }
            SEAM(base + 8);
        }
        if (IN(base + 9)) { row_pass(F, P, L, 2); SEAM(base + 9); }
    }
#undef IN
#undef SEAM
#undef R1
#undef R2
#undef BIG
}

extern "C" void kernel_launch(void* const* d_in, const int* in_sizes, int n_in, void* d_out, int out_size, void* d_ws, size_t ws_size, hipStream_t stream) {
    static int grid = 0;
    if (grid == 0) {
        if (n_in != 24 || out_size != ML * D || ws_size < WS_END) { fprintf(stderr, "kernel_launch: unexpected shapes (n_in %d, out %d, ws %zu < %zu)\n", n_in, out_size, ws_size, (size_t)WS_END); grid = -1; return; }
        int dev = 0, cus = 0;
        if (hipGetDevice(&dev) != hipSuccess || hipDeviceGetAttribute(&cus, hipDeviceAttributeMultiprocessorCount, dev) != hipSuccess) { grid = -1; return; }
        if (hipFuncSetAttribute((const void*)mk_fwd, hipFuncAttributeMaxDynamicSharedMemorySize, LDS_BYTES) != hipSuccess) { fprintf(stderr, "kernel_launch: hipFuncSetAttribute failed\n"); grid = -1; return; }
        int per_cu = 0;
        if (hipOccupancyMaxActiveBlocksPerMultiprocessor(&per_cu, (const void*)mk_fwd, NTHREADS, LDS_BYTES) != hipSuccess || per_cu < 1) fprintf(stderr, "kernel_launch: occupancy query says %d\n", per_cu);
        (void)hipGetLastError();
        grid = cus;
    }
    if (grid < 0) return;
    (void)hipMemsetAsync((char*)d_ws + WS_CTL, 0, (size_t)(CW_BAR + XCD_BAR_WORDS) * 4, stream);
    Args a{};
    for (int i = 0; i < 24; ++i) a.in[i] = (const float*)d_in[i];
    a.out = (float*)d_out; a.ws = (unsigned char*)d_ws;
#if MK_ONE_LAUNCH
    a.ph_lo = 0; a.ph_hi = N_PHASES;
    hipLaunchKernelGGL(mk_fwd, dim3(grid), dim3(NTHREADS), LDS_BYTES, stream, a);
#else
    for (int p = 0; p < N_PHASES; ++p) { if (!phase_exists(p)) continue; a.ph_lo = p; a.ph_hi = p + 1;
        hipLaunchKernelGGL(mk_fwd, dim3(grid), dim3(NTHREADS), LDS_BYTES, stream, a); }
#endif
}
```
